# Optimizing an MI355X kernel written in HIP

```python
import numpy as np
import jax, jax.numpy as jnp
from jax import lax

D_MODEL = 1024
BATCH = 4
SEQ = 8192
DEPTH = 1

D_CONV = D_MODEL
CONV_K = 3
HEAD_DIM = 64
N_HEADS = D_MODEL // HEAD_DIM
N_KV_HEADS = 4
GROUP = N_HEADS // N_KV_HEADS
D_ATTN = N_HEADS * HEAD_DIM
D_KV = N_KV_HEADS * HEAD_DIM
WINDOW = 128
BLOCK = 128
ROPE_THETA = 10000.0
D_FF = 2816
N_MOD = 9
EPS = 1e-6
ADA_INIT = 0.5
NEG_INF = -1e30

IN_SPLITS = [D_CONV, D_CONV, D_CONV, D_ATTN, D_KV, D_KV, D_MODEL, D_MODEL]
IN_OFFSETS = [int(o) for o in np.cumsum(IN_SPLITS)[:-1]]
D_IN = int(sum(IN_SPLITS))

kernel_name = "macaron_conv_swa_sink_hybrid"


def rms_norm(x, g):
    xf = x.astype(jnp.float32)
    y = xf * lax.rsqrt(jnp.mean(xf * xf, axis=-1, keepdims=True) + EPS)
    return (y * g.astype(jnp.float32)).astype(x.dtype)


def modulate(h, shift, scale):
    return h * (1 + scale[:, None, :]) + shift[:, None, :]


def swiglu(h, w_gu, w_down):
    a, b = jnp.split(h @ w_gu, 2, axis=-1)
    return (jax.nn.silu(a) * b) @ w_down


def rope_tables(seq):
    inv = 1.0 / (ROPE_THETA ** (jnp.arange(0, HEAD_DIM, 2, dtype=jnp.float32) / HEAD_DIM))
    ang = jnp.arange(seq, dtype=jnp.float32)[:, None] * inv[None, :]
    return jnp.cos(ang), jnp.sin(ang)


def apply_rope(t, cos, sin):
    t1, t2 = jnp.split(t.astype(jnp.float32), 2, axis=-1)
    c = cos[None, :, None, :]
    s = sin[None, :, None, :]
    return jnp.concatenate([t1 * c - t2 * s, t2 * c + t1 * s], axis=-1).astype(t.dtype)


def short_conv(u, w):
    s = u.shape[1]
    up = jnp.pad(u, ((0, 0), (CONV_K - 1, 0), (0, 0)))
    out = up[:, 0:s] * w[0]
    for j in range(1, CONV_K):
        out = out + up[:, j:j + s] * w[j]
    return out


def sliding_window_attention(q, k, v, sinks):
    bsz, s, _, _ = q.shape
    nb = s // BLOCK
    qb = q.reshape(bsz, nb, BLOCK, N_KV_HEADS, GROUP, HEAD_DIM)

    def band(t):
        tp = jnp.pad(t, ((0, 0), (BLOCK, 0), (0, 0), (0, 0)))
        tp = tp.reshape(bsz, nb + 1, BLOCK, N_KV_HEADS, HEAD_DIM)
        return jnp.concatenate([tp[:, :-1], tp[:, 1:]], axis=2)

    kb, vb = band(k), band(v)
    scores = jnp.einsum('bnqhgd,bnkhd->bnhgqk', qb, kb,
                        preferred_element_type=jnp.float32) * (HEAD_DIM ** -0.5)
    qi = jnp.arange(BLOCK)[:, None]
    kj = jnp.arange(2 * BLOCK)[None, :]
    diff = BLOCK + qi - kj
    in_window = (diff >= 0) & (diff < WINDOW)
    k_pos = (jnp.arange(nb)[:, None] - 1) * BLOCK + jnp.arange(2 * BLOCK)[None, :]
    valid = in_window[None] & (k_pos >= 0)[:, None, :]
    scores = jnp.where(valid[None, :, None, None], scores, NEG_INF)
    sink = sinks.astype(jnp.float32).reshape(N_KV_HEADS, GROUP)[None, None, :, :, None, None]
    m = jnp.maximum(jnp.max(scores, axis=-1, keepdims=True), sink)
    p = jnp.exp(scores - m)
    denom = jnp.sum(p, axis=-1, keepdims=True) + jnp.exp(sink - m)
    probs = (p / denom).astype(v.dtype)
    out = jnp.einsum('bnhgqk,bnkhd->bnqhgd', probs, vb)
    return out.reshape(bsz, s, D_ATTN)


def setup_inputs(seed: int = 0) -> dict:
    key = jax.random.key(seed)
    ks = jax.random.split(key, 24)
    f32 = jnp.float32

    def nrm(k, shape, fan_in, mult=1.0):
        return jax.random.normal(k, shape, f32) * (mult * fan_in ** -0.5)

    def gain(k, shape):
        return 1.0 + 0.05 * jax.random.normal(k, shape, f32)

    L = DEPTH
    return {
        "x": jax.random.normal(ks[0], (BATCH, SEQ, D_MODEL), f32),
        "c": jax.random.normal(ks[1], (BATCH, D_MODEL), f32),
        "w_ada": nrm(ks[2], (L, D_MODEL, N_MOD * D_MODEL), D_MODEL, ADA_INIT),
        "b_ada": 0.02 * jax.random.normal(ks[3], (L, N_MOD * D_MODEL), f32),
        "g_ffn1": gain(ks[4], (L, D_MODEL)),
        "w1_gu": nrm(ks[5], (L, D_MODEL, 2 * D_FF), D_MODEL),
        "w1_down": nrm(ks[6], (L, D_FF, D_MODEL), D_FF),
        "g_mix": gain(ks[7], (L, D_MODEL)),
        "w_in": nrm(ks[8], (L, D_MODEL, D_IN), D_MODEL),
        "conv_w": nrm(ks[9], (L, CONV_K, D_CONV), CONV_K),
        "w_conv_proj": nrm(ks[10], (L, D_CONV, D_MODEL), D_CONV),
        "w_attn_proj": nrm(ks[11], (L, D_ATTN, D_MODEL), D_ATTN),
        "sinks": jax.random.normal(ks[12], (L, N_HEADS), f32),
        "w_out": nrm(ks[13], (L, D_MODEL, D_MODEL), D_MODEL),
        "g_ffn2": gain(ks[14], (L, D_MODEL)),
        "w2_gu": nrm(ks[15], (L, D_MODEL, 2 * D_FF), D_MODEL),
        "w2_down": nrm(ks[16], (L, D_FF, D_MODEL), D_FF),
        "g_final": gain(ks[17], (D_MODEL,)),
    }


def reference(x, c, w_ada, b_ada, g_ffn1, w1_gu, w1_down, g_mix, w_in, conv_w,
              w_conv_proj, w_attn_proj, sinks, w_out, g_ffn2, w2_gu, w2_down, g_final):
    bsz, s, _ = x.shape
    cos, sin = rope_tables(s)
    c_act = jax.nn.silu(c)
    for l in range(DEPTH):
        mods = jnp.split(c_act @ w_ada[l] + b_ada[l], N_MOD, axis=-1)
        sh1, sc1, gt1, sh2, sc2, gt2, sh3, sc3, gt3 = mods

        h = modulate(rms_norm(x, g_ffn1[l]), sh1, sc1)
        x = x + 0.5 * gt1[:, None, :] * swiglu(h, w1_gu[l], w1_down[l])

        h = modulate(rms_norm(x, g_mix[l]), sh2, sc2)
        proj = h @ w_in[l]
        b_g, c_g, u, q, k, v, z_conv, z_attn = jnp.split(proj, IN_OFFSETS, axis=-1)

        y_conv = (b_g * short_conv(c_g * u, conv_w[l])) @ w_conv_proj[l]

        q = apply_rope(q.reshape(bsz, s, N_HEADS, HEAD_DIM), cos, sin)
        k = apply_rope(k.reshape(bsz, s, N_KV_HEADS, HEAD_DIM), cos, sin)
        v = v.reshape(bsz, s, N_KV_HEADS, HEAD_DIM)
        y_attn = sliding_window_attention(q, k, v, sinks[l]) @ w_attn_proj[l]

        merged = jax.nn.sigmoid(z_conv) * y_conv + jax.nn.sigmoid(z_attn) * y_attn
        x = x + gt2[:, None, :] * (merged @ w_out[l])

        h = modulate(rms_norm(x, g_ffn2[l]), sh3, sc3)
        x = x + 0.5 * gt3[:, None, :] * swiglu(h, w2_gu[l], w2_down[l])

    return rms_norm(x, g_final)
```

```cpp
#include <hip/hip_runtime.h>
#include <hip/hip_cooperative_groups.h>
#include <cstdio>
#include <cstdint>
#include <cmath>
namespace cg = cooperative_groups;
namespace pg8 {
#define PG8_LAS __attribute__((address_space(3)))
typedef unsigned short bf16_t;
typedef short bf16x8 __attribute__((ext_vector_type(8)));
typedef float f32x4 __attribute__((ext_vector_type(4)));
typedef unsigned u32x4 __attribute__((ext_vector_type(4)));
constexpr int BM = 256, BK = 64, HALF = 128, HTB = HALF * BK * 2  , STAGE_BYTES = 8 * HTB, NXCD = 8, WGM = 2;

__host__ __device__ __forceinline__ int lds_byte(int r, int c) { const int st = (r >> 4) * 2 + (c >> 5), rr = r & 15, cc = c & 31, ob = rr * 64 + cc * 2; return st * 1024 + (ob ^ (((ob >> 9) & 1) << 5)); }
__host__ __device__ __forceinline__ void stage_rc(int b, int& R, int& C) { const int st = b / 1024, sb = b % 1024, swz = sb ^ (((sb >> 9) & 1) << 5); R = (st >> 1) * 16 + swz / 64; C = (st & 1) * 32 + (swz % 64) / 2; }
__host__ __device__ __forceinline__ int perm32(int rho) { const int n = rho >> 4, i = rho & 15; return 8 * (i >> 2) + 4 * n + (i & 3); }

struct Unit { int pm, pn, sel; };
struct Gemm { const bf16_t* A; const bf16_t* Bt; int M, N, K; const bf16_t* A2; const bf16_t* Bt2; };

struct StaticOrder {
    int nM, nN, nwg, G, c;
    __host__ __device__ void init(int M, int N, int G_, int c_) { nM = M / BM; nN = N / BM; nwg = nM * nN; G = G_; c = c_; }
    __host__ __device__ bool next(int i, Unit& u) const {
        const long L = (long)i * G + c; if (L >= nwg) return false;
        int wgid = (int)L; { const int q = nwg / NXCD, r = nwg % NXCD, xcd = wgid % NXCD, off = wgid / NXCD; wgid = (xcd < r ? xcd * (q + 1) : r * (q + 1) + (xcd - r) * q) + off; }
        const int nig = WGM * nN, gid = wgid / nig, fm = gid * WGM, gsz = (nM - fm) < WGM ? (nM - fm) : WGM;
        u.pm = fm + ((wgid % nig) % gsz); u.pn = (wgid % nig) / gsz; if (gid & 1) u.pn = nN - 1 - u.pn;
        u.sel = 0; return true;
    }
    __device__ __forceinline__ void a_ready(const Unit&) const {}
    __device__ __forceinline__ void done(const Unit&) const {}
};

struct DualOrder {
    StaticOrder b;
    __host__ __device__ void init(int M, int N, int G_, int c_) { b.init(M, N, G_, c_); }
    __host__ __device__ bool next(int i, Unit& u) const { if (!b.next(i >> 1, u)) return false; u.sel = i & 1; return true; }
    __device__ __forceinline__ void a_ready(const Unit&) const {}
    __device__ __forceinline__ void done(const Unit&) const {}
};
__device__ __forceinline__ unsigned cvt_pk_bf16(float lo, float hi) { unsigned r; asm volatile("v_cvt_pk_bf16_f32 %0, %1, %2" : "=v"(r) : "v"(lo), "v"(hi)); return r; }
typedef float f32x2 __attribute__((ext_vector_type(2)));
template <class Epi, class Sched, bool ALIGN_EPI = false, bool SP2 = false>
__device__ __forceinline__ void gemm_phase(PG8_LAS unsigned char* lds, const Gemm g, const Sched& S, const Epi& E) {
    const int tid = threadIdx.x, wid = __builtin_amdgcn_readfirstlane(tid >> 6), lane = tid & 63, wr = wid >> 2, wc = wid & 3, fr = lane & 15, fq = lane >> 4;
    const int K = g.K, nt = K / BK;
    unsigned voffA[2], voffB[2];
#pragma unroll
    for (int i = 0; i < 2; ++i) { int R, C; stage_rc(tid * 16 + i * 8192, R, C); const int Rb = Epi::PERM ? ((R & ~31) + perm32(R & 31)) : R;
        voffA[i] = Epi::AIL ? (unsigned)((R >> 1) * (2 * K) + (C >> 5) * 64 + (R & 1) * 32 + (C & 31)) * 2u : (unsigned)(R * K + C) * 2u; voffB[i] = (unsigned)(Rb * K + C) * 2u; }
    const size_t kstep = (size_t)(BK * 2);
    const size_t kstepA = Epi::AIL ? (size_t)(BK * 4) : kstep;
    const size_t hstep = (size_t)HALF * K * 2;
    const size_t tstep = 2 * hstep;
    const unsigned ldsw = (unsigned)wid * 1024u;
    const int aoff = lds_byte(wr * 64 + fr, fq * 8), boff = lds_byte(wc * 32 + fr, fq * 8);
#define PG8_ABASE(u) ((const char*)((Epi::DUAL && (u).sel) ? g.A2 : g.A) + (size_t)(u).pm * tstep)
#define PG8_BBASE(u) ((const char*)((Epi::DUAL && (u).sel) ? g.Bt2 : g.Bt) + (size_t)(u).pn * tstep)
#define PG8_SA(b, h) (((b) * 2 + (h)) * HTB)
#define PG8_SB(b, h) ((4 + (b) * 2 + (h)) * HTB)
#define PG8_STAGE(bufoff, gbase, voff) do { _Pragma("unroll") for (int _i = 0; _i < 2; ++_i) \
        __builtin_amdgcn_global_load_lds((const unsigned*)((const char*)(gbase) + (voff)[_i]), (PG8_LAS unsigned*)(lds + (bufoff) + ldsw + _i * 8192), 16, 0, 0); } while (0)
#define PG8_LDA(dst, b, h) do { _Pragma("unroll") for (int m = 0; m < 4; ++m) _Pragma("unroll") for (int k = 0; k < 2; ++k) dst[m][k] = *(const PG8_LAS bf16x8*)(lds + PG8_SA(b, h) + aoff + m * 2048 + k * 1024); } while (0)
#define PG8_LDB(dst, b, h) do { _Pragma("unroll") for (int n = 0; n < 2; ++n) _Pragma("unroll") for (int k = 0; k < 2; ++k) dst[n][k] = *(const PG8_LAS bf16x8*)(lds + PG8_SB(b, h) + boff + n * 2048 + k * 1024); } while (0)
#define PG8_MMA(ai, bj, At, Bt) do { __builtin_amdgcn_s_setprio(1); _Pragma("unroll") for (int m = 0; m < 4; ++m) _Pragma("unroll") for (int n = 0; n < 2; ++n) _Pragma("unroll") for (int k = 0; k < 2; ++k) \
        acc[ai][bj][m][n] = __builtin_amdgcn_mfma_f32_16x16x32_bf16(Bt[n][k], At[m][k], acc[ai][bj][m][n], 0, 0, 0); __builtin_amdgcn_s_setprio(0); } while (0)
#define PG8_WAIT_V(n) asm volatile("s_waitcnt vmcnt(" #n ")" ::: "memory")
#define PG8_WAIT_L(n) asm volatile("s_waitcnt lgkmcnt(" #n ")" ::: "memory")
#define PG8_BAR __builtin_amdgcn_s_barrier()
#define PG8_SCHED __builtin_amdgcn_sched_barrier(0)
    Unit cur, nxt; int ui = 0;
    int tpf = 0; asm volatile("" : "+s"(tpf));
    if (!S.next(0, cur)) return;
    f32x4 acc[2][2][4][2];
#pragma unroll
    for (int a = 0; a < 2; ++a)
#pragma unroll
        for (int b = 0; b < 2; ++b)
#pragma unroll
            for (int m = 0; m < 4; ++m)
#pragma unroll
                for (int n = 0; n < 2; ++n) acc[a][b][m][n] = (f32x4){0.f, 0.f, 0.f, 0.f};
    bf16x8 At[4][2], B0[2][2], B1[2][2];
    const char* cA = PG8_ABASE(cur); const char* cB = PG8_BBASE(cur);
    S.a_ready(cur);
    if constexpr (SP2) {
        PG8_STAGE(PG8_SB(0, 0), cB, voffB); PG8_STAGE(PG8_SB(0, 1), cB + hstep, voffB); PG8_STAGE(PG8_SA(0, 0), cA, voffA); PG8_STAGE(PG8_SA(0, 1), cA + hstep, voffA);
        if (wr == 1) PG8_BAR;
        PG8_WAIT_V(2); PG8_BAR;
        PG8_STAGE(PG8_SB(1, 0), cB + kstep, voffB); PG8_STAGE(PG8_SA(1, 0), cA + kstepA, voffA); PG8_STAGE(PG8_SB(1, 1), cB + hstep + kstep, voffB);
        PG8_WAIT_V(6); PG8_BAR;
    } else {
        PG8_STAGE(PG8_SB(0, 0), cB, voffB); PG8_STAGE(PG8_SA(0, 0), cA, voffA); PG8_STAGE(PG8_SB(0, 1), cB + hstep, voffB); PG8_STAGE(PG8_SA(0, 1), cA + hstep, voffA);
        if (wr == 1) PG8_BAR;
        PG8_WAIT_V(4); PG8_BAR;
        PG8_STAGE(PG8_SB(1, 0), cB + kstep, voffB); PG8_STAGE(PG8_SA(1, 0), cA + kstepA, voffA); PG8_STAGE(PG8_SB(1, 1), cB + hstep + kstep, voffB);
        PG8_WAIT_V(6); PG8_BAR;
    }
    for (;;) {
        const bool has_next = S.next(ui + 1, nxt);
        const char* nA = has_next ? PG8_ABASE(nxt) : cA; const char* nB = has_next ? PG8_BBASE(nxt) : cB;
        for (int t = 0; t < nt; t += 2) {
            const bool last = (t == nt - 2);
            const char* a1 = cA + (size_t)(t + 1) * kstepA;
            const char* a2 = last ? nA : cA + (size_t)(t + 2) * kstepA; const char* b2 = last ? nB : cB + (size_t)(t + 2) * kstep;
            const char* a3 = a2 + kstepA; const char* b3 = b2 + kstep;
            if (last && has_next) S.a_ready(nxt);
            if constexpr (SP2) {
            PG8_LDB(B0, 0, 0); PG8_LDB(B1, 0, 1); PG8_SCHED; PG8_LDA(At, 0, 0); PG8_STAGE(PG8_SA(1, 1), a1 + hstep, voffA);
            PG8_WAIT_V(8); PG8_WAIT_L(0); PG8_BAR; PG8_MMA(0, 0, At, B0); PG8_MMA(0, 1, At, B1); PG8_BAR; PG8_SCHED;
            if constexpr (Epi::PREFETCH) { if (t == tpf) E.prefetch(cur, wid, lane); }
            PG8_LDA(At, 0, 1); PG8_STAGE(PG8_SB(0, 0), b2, voffB); PG8_STAGE(PG8_SB(0, 1), b2 + hstep, voffB); PG8_STAGE(PG8_SA(0, 0), a2, voffA);
            PG8_WAIT_V(8); PG8_WAIT_L(0); PG8_BAR; PG8_MMA(1, 0, At, B0); PG8_MMA(1, 1, At, B1); PG8_BAR; PG8_SCHED;
            PG8_LDB(B0, 1, 0); PG8_LDB(B1, 1, 1); PG8_SCHED; PG8_LDA(At, 1, 0); PG8_STAGE(PG8_SA(0, 1), a2 + hstep, voffA);
            PG8_WAIT_V(8); PG8_WAIT_L(0); PG8_BAR; PG8_MMA(0, 0, At, B0); PG8_MMA(0, 1, At, B1); PG8_BAR; PG8_SCHED;
            PG8_LDA(At, 1, 1); PG8_STAGE(PG8_SB(1, 0), b3, voffB); PG8_STAGE(PG8_SB(1, 1), b3 + hstep, voffB); PG8_STAGE(PG8_SA(1, 0), a3, voffA);
            PG8_WAIT_V(8); PG8_WAIT_L(0); PG8_BAR; PG8_MMA(1, 0, At, B0); PG8_MMA(1, 1, At, B1); PG8_BAR; PG8_SCHED;
            } else {
            PG8_LDB(B0, 0, 0); PG8_SCHED; PG8_LDA(At, 0, 0); PG8_STAGE(PG8_SA(1, 1), a1 + hstep, voffA);
            PG8_WAIT_L(8); PG8_BAR; PG8_WAIT_L(0); PG8_MMA(0, 0, At, B0); PG8_BAR; PG8_SCHED;
            PG8_LDB(B1, 0, 1); PG8_STAGE(PG8_SB(0, 0), b2, voffB);
            PG8_BAR; PG8_WAIT_L(0); PG8_MMA(0, 1, At, B1); PG8_BAR;
            PG8_LDA(At, 0, 1); PG8_STAGE(PG8_SA(0, 0), a2, voffA);
            PG8_BAR; PG8_WAIT_L(0); PG8_MMA(1, 0, At, B0); PG8_BAR; PG8_SCHED;
            PG8_STAGE(PG8_SB(0, 1), b2 + hstep, voffB);
            PG8_WAIT_V(6); PG8_BAR; PG8_MMA(1, 1, At, B1); PG8_BAR;
            PG8_LDB(B0, 1, 0); PG8_SCHED; PG8_LDA(At, 1, 0); PG8_STAGE(PG8_SA(0, 1), a2 + hstep, voffA);
            PG8_WAIT_L(8); PG8_BAR; PG8_WAIT_L(0); PG8_MMA(0, 0, At, B0); PG8_BAR; PG8_SCHED;
            PG8_LDB(B1, 1, 1); PG8_STAGE(PG8_SB(1, 0), b3, voffB);
            PG8_BAR; PG8_WAIT_L(0); PG8_MMA(0, 1, At, B1); PG8_BAR;
            PG8_LDA(At, 1, 1); PG8_STAGE(PG8_SA(1, 0), a3, voffA);
            PG8_BAR; PG8_WAIT_L(0); PG8_MMA(1, 0, At, B0); PG8_BAR; PG8_SCHED;
            PG8_STAGE(PG8_SB(1, 1), b3 + hstep, voffB);
            PG8_WAIT_V(6); PG8_BAR; PG8_MMA(1, 1, At, B1); PG8_BAR;
            }
        }
        if constexpr (ALIGN_EPI) { if (wr == 0) PG8_BAR; }
        if constexpr (!Epi::AFTER_DRAIN) { if constexpr (Epi::DUAL) { if (cur.sel == 0) E.mid(acc, cur, wr, wc, fr, fq); else E(acc, cur, wr, wc, fr, fq); } else { E(acc, cur, wr, wc, fr, fq); } S.done(cur); }
        if (!has_next) break;
        if (!(Epi::DUAL && cur.sel == 0))
#pragma unroll
        for (int a = 0; a < 2; ++a)
#pragma unroll
            for (int b = 0; b < 2; ++b)
#pragma unroll
                for (int m = 0; m < 4; ++m)
#pragma unroll
                    for (int n = 0; n < 2; ++n) acc[a][b][m][n] = (f32x4){0.f, 0.f, 0.f, 0.f};
        cur = nxt; cA = nA; cB = nB; ++ui;
        if constexpr (ALIGN_EPI) { if (wr == 1) PG8_BAR; }
    }
    PG8_WAIT_V(0);
    if constexpr (!ALIGN_EPI) { if (wr == 0) PG8_BAR; }
    PG8_BAR;
    if constexpr (Epi::AFTER_DRAIN) { E.fused(acc, cur, wr, wc, fr, fq, lds, wid, lane); S.done(cur); }
#undef PG8_SA
#undef PG8_ABASE
#undef PG8_BBASE
#undef PG8_SB
#undef PG8_STAGE
#undef PG8_LDA
#undef PG8_LDB
#undef PG8_MMA
#undef PG8_WAIT_V
#undef PG8_WAIT_L
#undef PG8_BAR
#undef PG8_SCHED
}
}

constexpr int BATCH = 4, SEQ = 8192, DM = 1024, M = BATCH * SEQ, DFF = 2816, NGU = 2 * DFF, DIN = 6656, NMODC = 9 * DM;
constexpr float RMS_EPS = 1e-6f;
enum { MOD_SH1 = 0, MOD_SC1, MOD_GT1, MOD_SH2, MOD_SC2, MOD_GT2, MOD_SH3, MOD_SC3, MOD_GT3 };

constexpr size_t MiB = 1u << 20;
constexpr size_t WS_MODS = 0, WS_BIAS2 = 256 * 1024, WS_BIAS3 = 384 * 1024, WS_CTL = 512 * 1024  , CTL_BYTES = 16384, WS_COS = 1 * MiB, WS_SIN = 2 * MiB;
constexpr size_t WS_SSQ2 = 3 * MiB, WS_SSQ3 = 5 * MiB, WS_SSQF = 7 * MiB;
constexpr size_t WS_W1GU = 9 * MiB, WS_W1DN = 20 * MiB, WS_WIN = 26 * MiB, WS_WC = 39 * MiB, WS_WA = 41 * MiB, WS_WO = 43 * MiB, WS_W2GU = 45 * MiB, WS_W2DN = 56 * MiB;
constexpr size_t WS_HB = 64 * MiB;
constexpr size_t WS_BG = 128 * MiB;
constexpr size_t WS_Q = 192 * MiB;
constexpr size_t WS_SZC = 256 * MiB, WS_SZA = 320 * MiB;
constexpr size_t WS_CU = 384 * MiB;
constexpr size_t WS_K = 448 * MiB, WS_V = 464 * MiB;
constexpr size_t WS_PART = 384 * MiB;
constexpr size_t WS_ACT1 = 128 * MiB, WS_ACT2 = 192 * MiB;
constexpr size_t WS_X3 = 128 * MiB;
constexpr size_t OUT_RES = 64 * MiB;
constexpr size_t WS_END = 512 * MiB;
static_assert(WS_W2DN + (size_t)DM * DFF * 2 <= WS_HB && WS_ACT2 + (size_t)M * DFF * 2 <= WS_PART, "ws map");

#define LAS __attribute__((address_space(3)))
constexpr int LDS_SCR = 131072, LDS_BARW = LDS_SCR + 17408, LDS_STG = LDS_BARW + 256, LDS_BYTES = LDS_STG + 8192;

struct Args {
    const float *x, *c, *w_ada, *b_ada, *g_ffn1, *w1_gu, *w1_down, *g_mix, *w_in, *conv_w, *w_conv_proj, *w_attn_proj, *sinks, *w_out, *g_ffn2, *w2_gu, *w2_down, *g_final;
    float* out; unsigned char* ws; float inv_freq[32]; int ph_lo, ph_hi;
};
#define XB_TMO      128
#define XB_XCNT(j)  (256  + 64 * (j))
#define XB_XSUB(j)  (1280 + 64 * (j))
#define XB_XGEN(j)  (2304 + 64 * (j))
#define XB_TOP      3328
#define XB_TOPGEN   3392
#define XCD_BAR_WORDS 3456
#define XB_SPIN_CAP (1u << 18)

__device__ __forceinline__ unsigned xb_ld(unsigned* p)              { return __hip_atomic_load(p, __ATOMIC_RELAXED, __HIP_MEMORY_SCOPE_AGENT); }
__device__ __forceinline__ unsigned xb_add(unsigned* p, unsigned v) { return __hip_atomic_fetch_add(p, v, __ATOMIC_RELAXED, __HIP_MEMORY_SCOPE_AGENT); }
__device__ __forceinline__ unsigned xb_xcc_id() { return (unsigned)__builtin_amdgcn_s_getreg((3 << 11) | 20) & 0xFu; }
#define XB_SPIN(cond, bar) do { unsigned _sp = 0; while (cond) { __builtin_amdgcn_s_sleep(1); \
    if ((++_sp & 255u) == 0u) { if (xb_ld(&(bar)[XB_TMO])) break; if (_sp > XB_SPIN_CAP) { atomicAdd(&(bar)[XB_TMO], 1u); break; } } } } while (0)

struct XcdBarrier {
    unsigned* bar; unsigned x;
    volatile LAS unsigned* st;
};

__device__ __forceinline__ XcdBarrier xcd_barrier_post(unsigned* bar, volatile LAS unsigned* st) {
    XcdBarrier b; b.bar = bar; b.x = xb_xcc_id(); b.st = st;
    if (threadIdx.x == 0) (void)xb_add(&bar[XB_XCNT(b.x)], 1u);
    return b;
}
__device__ __forceinline__ void xcd_barrier_complete(unsigned* bar, unsigned x, unsigned& nloc, unsigned& nx) {
    const unsigned G = gridDim.x * gridDim.y * gridDim.z;
    unsigned sum, cnt, mine, sp = 0u;
    for (;;) {
        sum = 0u; cnt = 0u; mine = 0u;
#pragma unroll
        for (unsigned j = 0; j < 16; ++j) { const unsigned c = xb_ld(&bar[XB_XCNT(j)]); sum += c; cnt += (c > 0u) ? 1u : 0u; mine = (j == x) ? c : mine; }
        if (sum == G) break;
        __builtin_amdgcn_s_sleep(1);
        if ((++sp & 255u) == 0u) { if (xb_ld(&bar[XB_TMO])) break; if (sp > XB_SPIN_CAP) { atomicAdd(&bar[XB_TMO], 1u); break; } }
    }
    nloc = mine > 0u ? mine : 1u; nx = cnt > 0u ? cnt : 1u;
}

__device__ __forceinline__ void xcd_barrier(const XcdBarrier& b) {
    asm volatile("s_waitcnt vmcnt(0)" ::: "memory");
    __syncthreads();
    if (threadIdx.x == 0) {
        unsigned* bar = b.bar;
        __builtin_amdgcn_s_waitcnt(0);
        unsigned nloc = b.st[0], nx = b.st[1];
        if (nloc == 0u) { xcd_barrier_complete(bar, b.x, nloc, nx); b.st[0] = nloc; b.st[1] = nx; }
        const unsigned old = xb_add(&bar[XB_XSUB(b.x)], 1u);
        const unsigned gen = old / nloc;
        if (old + 1u == (gen + 1u) * nloc) {
            __builtin_amdgcn_fence(__ATOMIC_RELEASE, "agent");
            asm volatile("s_waitcnt vmcnt(0)" ::: "memory");
            const unsigned og = xb_add(&bar[XB_TOP], 1u);
            const unsigned tg = og / nx;
            if (og + 1u == (tg + 1u) * nx) xb_add(&bar[XB_TOPGEN], 1u);
            else XB_SPIN(xb_ld(&bar[XB_TOPGEN]) == tg, bar);
            __builtin_amdgcn_fence(__ATOMIC_ACQUIRE, "agent");
            xb_add(&bar[XB_XGEN(b.x)], 1u);
            asm volatile("s_waitcnt vmcnt(0)" ::: "memory");
        } else {
            XB_SPIN(xb_ld(&bar[XB_XGEN(b.x)]) == gen, bar);
            __builtin_amdgcn_fence(__ATOMIC_ACQUIRE, "agent");
            asm volatile("s_waitcnt vmcnt(0)" ::: "memory");
        }
    }
    __syncthreads();
}

namespace pg8 {
typedef unsigned u32x2 __attribute__((ext_vector_type(2)));
typedef float f32x16 __attribute__((ext_vector_type(16)));
__device__ __forceinline__ u32x4 pack8(const f32x4 a, const f32x4 b) { u32x4 w; w.x = cvt_pk_bf16(a[0], a[1]); w.y = cvt_pk_bf16(a[2], a[3]); w.z = cvt_pk_bf16(b[0], b[1]); w.w = cvt_pk_bf16(b[2], b[3]); return w; }
__device__ __forceinline__ void unpack8(const u32x4 w, f32x4& a, f32x4& b) {
    a[0] = __uint_as_float(w.x << 16); a[1] = __uint_as_float(w.x & 0xffff0000u); a[2] = __uint_as_float(w.y << 16); a[3] = __uint_as_float(w.y & 0xffff0000u);
    b[0] = __uint_as_float(w.z << 16); b[1] = __uint_as_float(w.z & 0xffff0000u); b[2] = __uint_as_float(w.w << 16); b[3] = __uint_as_float(w.w & 0xffff0000u);
}
__device__ __forceinline__ float sigm(float v) { return __builtin_amdgcn_rcpf(1.f + __expf(-v)); }
__device__ __forceinline__ float rstd_from(const float* ssq, int row) {
    const f32x4* p = (const f32x4*)(ssq + (size_t)row * 16);
    const f32x4 s = (p[0] + p[1]) + (p[2] + p[3]);
    return __builtin_amdgcn_rsqf(((s[0] + s[1]) + (s[2] + s[3])) * (1.0f / DM) + RMS_EPS);
}
constexpr int EPI_SCR_BYTES = 17408;
__device__ __forceinline__ void epi_prefetch(PG8_LAS unsigned char* scr, const float* ssq, const float* bias_tile, const Unit& u, int wid, int lane) {
    unsigned lo = (unsigned)lane * 16u; asm volatile("" : "+v"(lo));
    const char* src = (const char*)(ssq + (size_t)u.pm * BM * 16 + wid * 512);
#pragma unroll
    for (int j = 0; j < 2; ++j) __builtin_amdgcn_global_load_lds((const unsigned*)(src + j * 1024 + lo), (PG8_LAS unsigned*)(scr + (wid * 2 + j) * 1024), 16, 0, 0);
    if (wid == 0) __builtin_amdgcn_global_load_lds((const unsigned*)((const char*)bias_tile + lo), (PG8_LAS unsigned*)(scr + 16384), 16, 0, 0);
}
__device__ __forceinline__ float rstd_lds(const PG8_LAS unsigned char* scr, int lrow) {
    const PG8_LAS f32x4* p = (const PG8_LAS f32x4*)(scr + lrow * 64);
    const f32x4 s = (p[0] + p[1]) + (p[2] + p[3]);
    return __builtin_amdgcn_rsqf(((s[0] + s[1]) + (s[2] + s[3])) * (1.0f / DM) + RMS_EPS);
}
#define EPI_LROW (ai * HALF + wr * 64 + m * 16 + fr)
__device__ __forceinline__ void store_lines(PG8_LAS unsigned char* stg, const u32x4 P0, const u32x4 P1, int fr, int fq, bf16_t* seg0, int pitch) {
    const int ln = fq * 16 + fr;
#pragma unroll
    for (int h = 0; h < 2; ++h) {
        if ((fr >> 3) == h) { *(PG8_LAS u32x4*)(stg + (fr & 7) * 128 + fq * 16) = P0; *(PG8_LAS u32x4*)(stg + (fr & 7) * 128 + 64 + fq * 16) = P1; }
        __builtin_amdgcn_wave_barrier(); asm volatile("" ::: "memory");
        const u32x4 v = *(const PG8_LAS u32x4*)(stg + ln * 16);
        __builtin_amdgcn_wave_barrier(); asm volatile("" ::: "memory");
        *(u32x4*)(seg0 + (size_t)(8 * h + (ln >> 3)) * pitch + (ln & 7) * 8) = v; }
}
#define EPI_ROWS _Pragma("unroll") for (int ai = 0; ai < 2; ++ai) _Pragma("unroll") for (int m = 0; m < 4; ++m)
#define EPI_ROW (u.pm * BM + ai * HALF + wr * 64 + m * 16 + fr)

template <bool NORM> struct EpiGU {
    static constexpr bool PERM = true, AFTER_DRAIN = false, DUAL = false, PREFETCH = NORM, AIL = false; static constexpr int EPI_VM = 8;
    bf16_t* act; const float* ssq; const float* bias; PG8_LAS unsigned char* scr;
    __device__ __forceinline__ void prefetch(const Unit& u, int wid, int lane) const { epi_prefetch(scr, ssq, bias + (size_t)(u.pm >> 5) * NGU + u.pn * BM, u, wid, lane); }
    __device__ __forceinline__ void operator()(const f32x4 (&acc)[2][2][4][2], const Unit& u, int wr, int wc, int fr, int fq) const {
        asm volatile("" : "+v"(fr), "+v"(fq));
        const int b = u.pm >> 5, tcol = wc * 32 + fq * 8;
        f32x4 ba0 = {0.f, 0.f, 0.f, 0.f}, ba1 = ba0, bb0 = ba0, bb1 = ba0;
        if (NORM) { const PG8_LAS float* bp = (const PG8_LAS float*)(scr + 16384) + tcol; ba0 = *(const PG8_LAS f32x4*)bp; ba1 = *(const PG8_LAS f32x4*)(bp + 4); bb0 = *(const PG8_LAS f32x4*)(bp + HALF); bb1 = *(const PG8_LAS f32x4*)(bp + HALF + 4); }
        float rsv[2][4];
        if (NORM) { EPI_ROWS { rsv[ai][m] = rstd_lds(scr, EPI_LROW); asm volatile("" : "+v"(rsv[ai][m]) :: "memory"); } }
        EPI_ROWS { const int row = EPI_ROW;
            f32x4 a0 = acc[ai][0][m][0], a1 = acc[ai][0][m][1], b0 = acc[ai][1][m][0], b1 = acc[ai][1][m][1];
            if (NORM) { const float rs = rsv[ai][m]; a0 = a0 * rs + ba0; a1 = a1 * rs + ba1; b0 = b0 * rs + bb0; b1 = b1 * rs + bb1; }
            f32x4 o0, o1;
#pragma unroll
            for (int i = 0; i < 4; ++i) { o0[i] = a0[i] * sigm(a0[i]) * b0[i]; o1[i] = a1[i] * sigm(a1[i]) * b1[i]; }
            *(u32x4*)(act + (size_t)(row >> 1) * (2 * DFF) + (u.pn * 4 + wc) * 64 + (row & 1) * 32 + fq * 8) = pack8(o0, o1); }
    }
};

template <bool HALFG, bool XS, bool XOLD16, bool AIL_> struct EpiRes {
    static constexpr bool PERM = true, AFTER_DRAIN = false, DUAL = false, PREFETCH = false, AIL = AIL_;
    const void* xold; bf16_t* xnew; const float* gate; bf16_t* xs; const float* gcol; const float* scm; float* ssq; PG8_LAS unsigned char* stg;
    __device__ __forceinline__ void operator()(const f32x4 (&acc)[2][2][4][2], const Unit& u, int wr, int wc, int fr, int fq) const {
        asm volatile("" : "+v"(fr), "+v"(fq));
        const int b = u.pm >> 5, col0 = u.pn * BM + wc * 64 + fq * 8;
        PG8_LAS unsigned char* st = stg + (wr * 4 + wc) * 1024;
        f32x4 gv[2][2], cs[2][2];
#pragma unroll
        for (int bj = 0; bj < 2; ++bj)
#pragma unroll
            for (int n = 0; n < 2; ++n) { const int c = col0 + bj * 32 + 4 * n; gv[bj][n] = *(const f32x4*)(gate + (size_t)b * NMODC + c) * (HALFG ? 0.5f : 1.0f);
                cs[bj][n] = (f32x4){0.f, 0.f, 0.f, 0.f}; if (XS) cs[bj][n] = *(const f32x4*)(gcol + c) * (*(const f32x4*)(scm + (size_t)b * NMODC + c) + 1.0f); }
        u32x4 c16[2], n16[2]; f32x4 c32[2][2], n32[2][2];
#define RES_LOAD(D16, D32, r_) do { const size_t ro_ = (size_t)(u.pm * BM + ((r_) >> 2) * HALF + wr * 64 + ((r_) & 3) * 16 + fr) * DM + col0; _Pragma("unroll") for (int bj = 0; bj < 2; ++bj) { \
            if (XOLD16) D16[bj] = *(const u32x4*)((const bf16_t*)xold + ro_ + bj * 32); else { D32[bj][0] = *(const f32x4*)((const float*)xold + ro_ + bj * 32); D32[bj][1] = *(const f32x4*)((const float*)xold + ro_ + bj * 32 + 4); } } } while (0)
        RES_LOAD(c16, c32, 0);
#pragma unroll
        for (int r = 0; r < 8; ++r) { const int ai = r >> 2, m = r & 3; const int row = EPI_ROW; float sq = 0.f;
            if (r < 7) RES_LOAD(n16, n32, r + 1);
            u32x4 pn_[2], ps_[2];
#pragma unroll
            for (int bj = 0; bj < 2; ++bj) {
                f32x4 o0, o1;
                if (XOLD16) unpack8(c16[bj], o0, o1); else { o0 = c32[bj][0]; o1 = c32[bj][1]; }
                const f32x4 v0 = o0 + gv[bj][0] * acc[ai][bj][m][0], v1 = o1 + gv[bj][1] * acc[ai][bj][m][1];
                pn_[bj] = pack8(v0, v1);
                sq += ((v0[0] * v0[0] + v0[1] * v0[1]) + (v0[2] * v0[2] + v0[3] * v0[3])) + ((v1[0] * v1[0] + v1[1] * v1[1]) + (v1[2] * v1[2] + v1[3] * v1[3]));
                if (XS) ps_[bj] = pack8(v0 * cs[bj][0], v1 * cs[bj][1]); }
            { const size_t seg = (size_t)(row - fr) * DM + u.pn * BM + wc * 64;
              store_lines(st, pn_[0], pn_[1], fr, fq, xnew + seg, DM);
              if (XS) store_lines(st, ps_[0], ps_[1], fr, fq, xs + seg, DM); }
            sq += __shfl_xor(sq, 16); sq += __shfl_xor(sq, 32);
            if (fq == 0) ssq[(size_t)row * 16 + u.pn * 4 + wc] = sq;
#pragma unroll
            for (int bj = 0; bj < 2; ++bj) { c16[bj] = n16[bj]; c32[bj][0] = n32[bj][0]; c32[bj][1] = n32[bj][1]; } }
#undef RES_LOAD
    }
};

struct EpiIn {
    static constexpr bool PERM = true, AFTER_DRAIN = false, DUAL = false, PREFETCH = true, AIL = false; static constexpr int EPI_VM = 8;
    PG8_LAS unsigned char* scr; PG8_LAS unsigned char* stg;
    __device__ __forceinline__ void prefetch(const Unit& u, int wid, int lane) const { epi_prefetch(scr, ssq, bias + (size_t)(u.pm >> 5) * DIN + u.pn * BM, u, wid, lane); }
    const float* ssq; const float* bias; const float* cosT; const float* sinT; bf16_t *BG, *CU, *Q, *K, *V, *SZC, *SZA;
    __device__ __forceinline__ void operator()(const f32x4 (&acc)[2][2][4][2], const Unit& u, int wr, int wc, int fr, int fq) const {
        asm volatile("" : "+v"(fr), "+v"(fq));
        const int b = u.pm >> 5, tcol = wc * 32 + fq * 8, pn = u.pn;
        const PG8_LAS float* bp = (const PG8_LAS float*)(scr + 16384) + tcol;
        const f32x4 ba0 = *(const PG8_LAS f32x4*)bp, ba1 = *(const PG8_LAS f32x4*)(bp + 4), bb0 = *(const PG8_LAS f32x4*)(bp + HALF), bb1 = *(const PG8_LAS f32x4*)(bp + HALF + 4);
        int mode, pitch, c0, c1; bf16_t* dst;
        if (pn < 4)       { mode = 0; dst = BG;  pitch = DM;  c0 = pn * BM + wc * 64 + fq * 8; c1 = c0 + 32; }
        else if (pn < 12) { mode = 1; dst = CU;  pitch = DM;  c0 = (pn - 4) * HALF + tcol; c1 = c0; }
        else if (pn < 16) { mode = 2; dst = Q;   pitch = DM;  c0 = (4 * (pn - 12) + wc) * 64 + fq * 8; c1 = c0 + 32; }
        else if (pn < 17) { mode = 2; dst = K;   pitch = 256; c0 = wc * 64 + fq * 8; c1 = c0 + 32; }
        else if (pn < 18) { mode = 0; dst = V;   pitch = 256; c0 = wc * 64 + fq * 8; c1 = c0 + 32; }
        else              { mode = 3; dst = SZC; pitch = DM;  c0 = (pn - 18) * HALF + tcol; c1 = c0; }
        float rsv[2][4];
        EPI_ROWS { rsv[ai][m] = rstd_lds(scr, EPI_LROW); asm volatile("" : "+v"(rsv[ai][m]) :: "memory"); }
#define ROPE_LOAD(C0, C1, S0, S1, r_) do { const int pos_ = (u.pm * BM + ((r_) >> 2) * HALF + wr * 64 + ((r_) & 3) * 16 + fr) & (SEQ - 1); const float* cp_ = cosT + pos_ * 32 + fq * 8; const float* sp_ = sinT + pos_ * 32 + fq * 8; \
            C0 = *(const f32x4*)cp_; C1 = *(const f32x4*)(cp_ + 4); S0 = *(const f32x4*)sp_; S1 = *(const f32x4*)(sp_ + 4); } while (0)
#pragma unroll
        for (int r = 0; r < 8; ++r) { const int ai = r >> 2, m = r & 3; const int row = EPI_ROW; const float rs = rsv[ai][m];
            f32x4 a0 = acc[ai][0][m][0] * rs + ba0, a1 = acc[ai][0][m][1] * rs + ba1, b0 = acc[ai][1][m][0] * rs + bb0, b1 = acc[ai][1][m][1] * rs + bb1;
            bf16_t* rp = dst + (size_t)row * pitch;
            if (mode == 1) { *(u32x4*)(rp + c0) = pack8(a0 * b0, a1 * b1); }
            else if (mode == 3) {
#pragma unroll
                for (int i = 0; i < 4; ++i) {
                    const float ea0 = __expf(-a0[i]), ea1 = __expf(-a1[i]), eb0 = __expf(-b0[i]), eb1 = __expf(-b1[i]);
                    a0[i] = (1.f + eb0) * __builtin_amdgcn_rcpf(1.f + ea0); a1[i] = (1.f + eb1) * __builtin_amdgcn_rcpf(1.f + ea1); b0[i] = __builtin_amdgcn_rcpf(1.f + eb0); b1[i] = __builtin_amdgcn_rcpf(1.f + eb1); }
                { const size_t po = (size_t)(row >> 1) * (2 * DM) + ((pn - 18) * 4 + wc) * 64 + (row & 1) * 32 + fq * 8;
                  *(u32x4*)(SZC + po) = pack8(a0, a1); *(u32x4*)(SZA + po) = pack8(b0, b1); } }
            else {
                if (mode == 2) { f32x4 cA, cB, sA, sB; ROPE_LOAD(cA, cB, sA, sB, r); const f32x4 x0 = a0, x1 = a1, y0 = b0, y1 = b1;
                    a0 = x0 * cA - y0 * sA; a1 = x1 * cB - y1 * sB; b0 = y0 * cA + x0 * sA; b1 = y1 * cB + x1 * sB; }
                store_lines(stg + (wr * 4 + wc) * 1024, pack8(a0, a1), pack8(b0, b1), fr, fq, dst + (size_t)(row - fr) * pitch + (c0 - fq * 8), pitch); } }
#undef ROPE_LOAD
    }
};

struct EpiDual {
    static constexpr bool PERM = true, AFTER_DRAIN = false, DUAL = true, PREFETCH = false, AIL = false; static constexpr int EPI_VM = 16;
    const bf16_t* rz; const bf16_t* sa; bf16_t* mg; PG8_LAS unsigned char* stg;
    __device__ __forceinline__ void mid(f32x4 (&acc)[2][2][4][2], const Unit& u, int wr, int wc, int fr, int fq) const {
        asm volatile("" : "+v"(fr), "+v"(fq));
        const int col0 = u.pn * BM + wc * 64 + fq * 8;
        EPI_ROWS { const int row = EPI_ROW;
#pragma unroll
            for (int bj = 0; bj < 2; ++bj) { const size_t off = (size_t)(row >> 1) * (2 * DM) + (u.pn * 8 + wc * 2 + bj) * 64 + (row & 1) * 32 + fq * 8; f32x4 g0, g1; unpack8(*(const u32x4*)(rz + off), g0, g1);
                acc[ai][bj][m][0] *= g0; acc[ai][bj][m][1] *= g1; } }
    }
    __device__ __forceinline__ void operator()(const f32x4 (&acc)[2][2][4][2], const Unit& u, int wr, int wc, int fr, int fq) const {
        asm volatile("" : "+v"(fr), "+v"(fq));
        const int col0 = u.pn * BM + wc * 64 + fq * 8;
        u32x4 cg[2], ng[2];
#define SA_LOAD(D, r_) do { const int rw_ = u.pm * BM + ((r_) >> 2) * HALF + wr * 64 + ((r_) & 3) * 16 + fr; const size_t ro_ = (size_t)(rw_ >> 1) * (2 * DM) + (u.pn * 8 + wc * 2) * 64 + (rw_ & 1) * 32 + fq * 8; D[0] = *(const u32x4*)(sa + ro_); D[1] = *(const u32x4*)(sa + ro_ + 64); } while (0)
        SA_LOAD(cg, 0);
#pragma unroll
        for (int r = 0; r < 8; ++r) { const int ai = r >> 2, m = r & 3; const int row = EPI_ROW;
            if (r < 7) SA_LOAD(ng, r + 1);
            u32x4 pm_[2];
#pragma unroll
            for (int bj = 0; bj < 2; ++bj) { f32x4 g0, g1; unpack8(cg[bj], g0, g1); pm_[bj] = pack8(g0 * acc[ai][bj][m][0], g1 * acc[ai][bj][m][1]); }
            store_lines(stg + (wr * 4 + wc) * 1024, pm_[0], pm_[1], fr, fq, mg + (size_t)(row - fr) * DM + u.pn * BM + wc * 64, DM);
            cg[0] = ng[0]; cg[1] = ng[1]; }
#undef SA_LOAD
    }
};
}
using pg8::bf16_t; using pg8::f32x4; using pg8::u32x4; using pg8::u32x2; using pg8::bf16x8; using pg8::f32x16;

__device__ __forceinline__ float wave_sum(float v) {
#pragma unroll
    for (int o = 1; o < 64; o <<= 1) v += __shfl_xor(v, o);
    return v;
}
__device__ __forceinline__ unsigned f2bf(float f) { unsigned u = __builtin_bit_cast(unsigned, f); return (u + 0x7fffu + ((u >> 16) & 1u)) >> 16; }
__device__ __forceinline__ unsigned pk2(float lo, float hi) { return f2bf(lo) | (f2bf(hi) << 16); }

__device__ __forceinline__ int wcperm(int n0) { const int t = n0 & 255; return (n0 & ~255) + 128 * ((t >> 5) & 1) + 32 * (t >> 6); }
__device__ __forceinline__ int dest_row(int kind, int n0) {
    if (kind == 1) { const int half = n0 >= DFF, j = half ? n0 - DFF : n0; return 256 * (j >> 7) + 128 * half + (j & 127); }
    if (kind == 2) {
        if (n0 < 1024) return wcperm(n0);
        if (n0 < 3072) { const int half = n0 >= 2048, j = (n0 - 1024) & 1023; return 1024 + 256 * (j >> 7) + 128 * half + (j & 127); }
        if (n0 < 4352) { const int base = n0 < 4096 ? 3072 : 4096, j = n0 - base, head = j >> 6, dd = j & 63; return base + 256 * (head >> 2) + 128 * (dd >> 5) + 32 * (head & 3) + (dd & 31); }
        if (n0 >= 4608) { const int half = n0 >= 5632, j = (n0 - 4608) & 1023; return 4608 + 256 * (j >> 7) + 128 * half + (j & 127); }
        return wcperm(n0);
    }
    if (kind == 3) return wcperm(n0);
    return n0;
}
__device__ __forceinline__ void p0_transpose_item(const float* W, int K, int N, bf16_t* WT, int kind, LAS float* scr, int item, int lane) {
    const int nblk = N / 32, kb = item / nblk, nb = item % nblk, k0 = 64 * kb, n0 = 32 * nb, dr0 = dest_row(kind, n0);
#pragma unroll 8
    for (int i = 0; i < 32; ++i) { const int kk = 2 * i + (lane >> 5); scr[kk * 33 + (lane & 31)] = W[(size_t)(k0 + kk) * N + n0 + (lane & 31)]; }
    asm volatile("s_waitcnt lgkmcnt(0)" ::: "memory");
    const int c = lane & 7;
#pragma unroll
    for (int j = 0; j < 4; ++j) { const int n = (lane >> 3) + 8 * j; const LAS float* s = scr + (8 * c) * 33 + n;
        u32x4 o; o.x = pk2(s[0 * 33], s[1 * 33]); o.y = pk2(s[2 * 33], s[3 * 33]); o.z = pk2(s[4 * 33], s[5 * 33]); o.w = pk2(s[6 * 33], s[7 * 33]);
        *(u32x4*)(WT + (size_t)(dr0 + n) * K + k0 + 8 * c) = o; }
    asm volatile("s_waitcnt lgkmcnt(0)" ::: "memory");
}

__device__ __forceinline__ void p0_prologue(const Args& A, LAS unsigned char* lds, int tid, int lane, int wave) {
    unsigned char* ws = A.ws;
    float* mods = (float*)(ws + WS_MODS);
    {
        LAS float* sc = (LAS float*)lds; LAS float* red = (LAS float*)(lds + 16384);
        for (int i = tid; i < BATCH * DM; i += 512) { const float v = A.c[i]; sc[i] = v / (1.f + expf(-v)); }
        __syncthreads();
        for (int item = blockIdx.x; item < NMODC / 64; item += gridDim.x) {
            const float* wp = A.w_ada + (size_t)(wave * 128) * NMODC + item * 64 + lane;
            float a0 = 0.f, a1 = 0.f, a2 = 0.f, a3 = 0.f;
#pragma unroll 8
            for (int k = 0; k < 128; ++k) { const float w = wp[(size_t)k * NMODC]; const int kk = wave * 128 + k;
                a0 += sc[kk] * w; a1 += sc[DM + kk] * w; a2 += sc[2 * DM + kk] * w; a3 += sc[3 * DM + kk] * w; }
            red[(wave * 4 + 0) * 64 + lane] = a0; red[(wave * 4 + 1) * 64 + lane] = a1; red[(wave * 4 + 2) * 64 + lane] = a2; red[(wave * 4 + 3) * 64 + lane] = a3;
            __syncthreads();
            if (tid < 256) { const int b = tid >> 6, col = tid & 63; float s = A.b_ada[item * 64 + col];
#pragma unroll
                for (int w = 0; w < 8; ++w) s += red[(w * 4 + b) * 64 + col];
                mods[(size_t)b * NMODC + item * 64 + col] = s; }
            __syncthreads();
        }
        __syncthreads();
    }
    {
        float* cosT = (float*)(ws + WS_COS); float* sinT = (float*)(ws + WS_SIN);
        for (int e = blockIdx.x * 512 + tid; e < SEQ * 32; e += gridDim.x * 512) {
            const int pos = e >> 5, i = e & 31; const float angf = (float)pos * A.inv_freq[i];
            const double a = (double)angf, kq = rint(a * 0.63661977236758134308), r = fma(-kq, 6.123233995736766e-17, fma(-kq, 1.5707963267948966, a)), r2 = r * r;
            double sn = -1.0 / 1307674368000.0; sn = sn * r2 + 1.0 / 6227020800.0; sn = sn * r2 - 1.0 / 39916800.0; sn = sn * r2 + 1.0 / 362880.0; sn = sn * r2 - 1.0 / 5040.0; sn = sn * r2 + 1.0 / 120.0; sn = sn * r2 - 1.0 / 6.0; sn = sn * r2 * r + r;
            double cs = 1.0 / 20922789888000.0; cs = cs * r2 - 1.0 / 87178291200.0; cs = cs * r2 + 1.0 / 479001600.0; cs = cs * r2 - 1.0 / 3628800.0; cs = cs * r2 + 1.0 / 40320.0; cs = cs * r2 - 1.0 / 720.0; cs = cs * r2 + 1.0 / 24.0; cs = cs * r2 - 0.5; cs = cs * r2 + 1.0;
            const int qd = ((int)kq) & 3;
            const double sv = (qd == 0) ? sn : (qd == 1) ? cs : (qd == 2) ? -sn : -cs;
            const double cv = (qd == 0) ? cs : (qd == 1) ? -sn : (qd == 2) ? -cs : sn;
            cosT[e] = (float)cv; sinT[e] = (float)sv;
        }
    }
    {
        LAS float* scr = (LAS float*)(lds + wave * 16384);
        const int gw = blockIdx.x * 8 + wave, NGW = gridDim.x * 8;
        constexpr int I_GU = (DM / 64) * (NGU / 32), I_DN = (DFF / 64) * (DM / 32), I_IN = (DM / 64) * (DIN / 32), I_SQ = (DM / 64) * (DM / 32);
        constexpr int NITEMS = 2 * I_GU + 2 * I_DN + I_IN + 3 * I_SQ;
        for (int it = gw; it < NITEMS; it += NGW) {
            int r = it;
            if (r < I_GU) { p0_transpose_item(A.w1_gu, DM, NGU, (bf16_t*)(ws + WS_W1GU), 1, scr, r, lane); continue; } r -= I_GU;
            if (r < I_DN) { p0_transpose_item(A.w1_down, DFF, DM, (bf16_t*)(ws + WS_W1DN), 3, scr, r, lane); continue; } r -= I_DN;
            if (r < I_IN) { p0_transpose_item(A.w_in, DM, DIN, (bf16_t*)(ws + WS_WIN), 2, scr, r, lane); continue; } r -= I_IN;
            if (r < I_SQ) { p0_transpose_item(A.w_conv_proj, DM, DM, (bf16_t*)(ws + WS_WC), 3, scr, r, lane); continue; } r -= I_SQ;
            if (r < I_SQ) { p0_transpose_item(A.w_attn_proj, DM, DM, (bf16_t*)(ws + WS_WA), 3, scr, r, lane); continue; } r -= I_SQ;
            if (r < I_SQ) { p0_transpose_item(A.w_out, DM, DM, (bf16_t*)(ws + WS_WO), 3, scr, r, lane); continue; } r -= I_SQ;
            if (r < I_GU) { p0_transpose_item(A.w2_gu, DM, NGU, (bf16_t*)(ws + WS_W2GU), 1, scr, r, lane); continue; } r -= I_GU;
            p0_transpose_item(A.w2_down, DFF, DM, (bf16_t*)(ws + WS_W2DN), 3, scr, r, lane);
        }
    }
}

__device__ __forceinline__ void p1_rows(const Args& A, int lane, int wave) {
    unsigned char* ws = A.ws; const float* mods = (const float*)(ws + WS_MODS);
    const int gw = blockIdx.x * 8 + wave, NGW = gridDim.x * 8;
    bf16_t* HB = (bf16_t*)(ws + WS_HB);
    f32x4 nx[4];
    if (gw < M) {
#pragma unroll
        for (int j = 0; j < 4; ++j) nx[j] = ((const f32x4*)(A.x + (size_t)gw * DM) + lane)[64 * j]; }
    for (int m = gw; m < M; m += NGW) {
        const int b = m >> 13;
        f32x4 v[4]; float s = 0.f;
#pragma unroll
        for (int j = 0; j < 4; ++j) v[j] = nx[j];
        if (m + NGW < M) {
#pragma unroll
            for (int j = 0; j < 4; ++j) nx[j] = ((const f32x4*)(A.x + (size_t)(m + NGW) * DM) + lane)[64 * j]; }
#pragma unroll
        for (int j = 0; j < 4; ++j) s += (v[j][0] * v[j][0] + v[j][1] * v[j][1]) + (v[j][2] * v[j][2] + v[j][3] * v[j][3]);
        const float rstd = 1.0f / sqrtf(wave_sum(s) * (1.0f / DM) + RMS_EPS);
        u32x2* o8 = (u32x2*)(HB + (size_t)m * DM) + lane;
#pragma unroll
        for (int j = 0; j < 4; ++j) { const int c = 4 * lane + 256 * j;
            const f32x4 g = *(const f32x4*)(A.g_ffn1 + c), sc = *(const f32x4*)(mods + (size_t)b * NMODC + MOD_SC1 * DM + c), sh = *(const f32x4*)(mods + (size_t)b * NMODC + MOD_SH1 * DM + c);
            const f32x4 h = (v[j] * rstd) * g * (sc + 1.0f) + sh;
            u32x2 w; w.x = pg8::cvt_pk_bf16(h[0], h[1]); w.y = pg8::cvt_pk_bf16(h[2], h[3]); o8[64 * j] = w; }
    }
    for (int it = gw; it < DIN + NGU; it += NGW) {
        const bool second = it >= DIN; const int dr = second ? it - DIN : it;
        const bf16_t* wrow = (const bf16_t*)(ws + (second ? WS_W2GU : WS_WIN)) + (size_t)dr * DM;
        const float* sh = mods + (second ? MOD_SH3 : MOD_SH2) * DM;
        float a0 = 0.f, a1 = 0.f, a2 = 0.f, a3 = 0.f;
#pragma unroll
        for (int j = 0; j < 2; ++j) { const int k = 8 * lane + 512 * j; f32x4 wa, wb; pg8::unpack8(*(const u32x4*)(wrow + k), wa, wb);
#define BDOT(acc_, bb) { const f32x4 s0 = *(const f32x4*)(sh + (size_t)(bb) * NMODC + k), s1 = *(const f32x4*)(sh + (size_t)(bb) * NMODC + k + 4); \
            acc_ += ((wa[0] * s0[0] + wa[1] * s0[1]) + (wa[2] * s0[2] + wa[3] * s0[3])) + ((wb[0] * s1[0] + wb[1] * s1[1]) + (wb[2] * s1[2] + wb[3] * s1[3])); }
            BDOT(a0, 0) BDOT(a1, 1) BDOT(a2, 2) BDOT(a3, 3)
#undef BDOT
        }
        a0 = wave_sum(a0); a1 = wave_sum(a1); a2 = wave_sum(a2); a3 = wave_sum(a3);
        if (lane == 0) { float* bo = (float*)(ws + (second ? WS_BIAS3 : WS_BIAS2)); const int N = second ? NGU : DIN;
            bo[dr] = a0; bo[N + dr] = a1; bo[2 * N + dr] = a2; bo[3 * N + dr] = a3; }
    }
}

__device__ __forceinline__ void p5_conv(const Args& A, int lane, int wave, bf16_t* Gout) {
    unsigned char* ws = A.ws; const bf16_t* BG = (const bf16_t*)(ws + WS_BG); const bf16_t* CU = (const bf16_t*)(ws + WS_CU);
    const int gw = blockIdx.x * 8 + wave, NGW = gridDim.x * 8;
    for (int wi = gw; wi < (M / 32) * 2; wi += NGW) {
        const int r0 = (wi >> 1) * 32, c0 = (wi & 1) * 512 + lane * 8;
        const f32x4 w0a = *(const f32x4*)(A.conv_w + c0), w0b = *(const f32x4*)(A.conv_w + c0 + 4), w1a = *(const f32x4*)(A.conv_w + DM + c0), w1b = *(const f32x4*)(A.conv_w + DM + c0 + 4),
                    w2a = *(const f32x4*)(A.conv_w + 2 * DM + c0), w2b = *(const f32x4*)(A.conv_w + 2 * DM + c0 + 4);
        f32x4 p2a = {0.f, 0.f, 0.f, 0.f}, p2b = p2a, p1a = p2a, p1b = p2a;
        if ((r0 & (SEQ - 1)) != 0) { pg8::unpack8(*(const u32x4*)(CU + (size_t)(r0 - 2) * DM + c0), p2a, p2b); pg8::unpack8(*(const u32x4*)(CU + (size_t)(r0 - 1) * DM + c0), p1a, p1b); }
        u32x4 cq[4], bq[4];
#pragma unroll
        for (int i = 0; i < 4; ++i) { const size_t off = (size_t)(r0 + i) * DM + c0; cq[i] = *(const u32x4*)(CU + off); bq[i] = *(const u32x4*)(BG + off); }
#pragma unroll
        for (int t = 0; t < 32; ++t) { const size_t off = (size_t)(r0 + t) * DM + c0;
            f32x4 ca, cb, ba, bb; pg8::unpack8(cq[t & 3], ca, cb); pg8::unpack8(bq[t & 3], ba, bb);
            if (t + 4 < 32) { const size_t offn = (size_t)(r0 + t + 4) * DM + c0; cq[t & 3] = *(const u32x4*)(CU + offn); bq[t & 3] = *(const u32x4*)(BG + offn); }
            const f32x4 oa = ba * ((w0a * p2a + w1a * p1a) + w2a * ca), ob = bb * ((w0b * p2b + w1b * p1b) + w2b * cb);
            *(u32x4*)(Gout + off) = pg8::pack8(oa, ob);
            p2a = p1a; p2b = p1b; p1a = ca; p1b = cb; }
    }
}

constexpr int KS_OFF = 0, KS_PITCH = 144, VS_OFF = 256 * KS_PITCH, VS_PITCH = 528, OS_OFF = VS_OFF + 64 * VS_PITCH, OS_PITCH = 144, OS_WAVE = 32 * OS_PITCH;
__device__ __forceinline__ void attn_unit(LAS unsigned char* lds, const bf16_t* Q, bf16_t* O, const bf16_t* Kb, const bf16_t* Vb, const float* sinks, int unit, int tid, int lane, int wid, int chain_ui) {
    const int n = unit & 63, g = (unit >> 6) & 3, b = unit >> 8;
    const int r0 = b * SEQ + n * 128;
    const int q = lane & 31, hi = lane >> 5, hq = wid >> 1, head = 4 * g + hq;
    bf16x8 Qf[2][4];
#pragma unroll
    for (int it = 0; it < 2; ++it) { const bf16_t* qp = Q + (size_t)(r0 + 32 * ((wid & 1) * 2 + it) + q) * DM + head * 64;
#pragma unroll
        for (int d0 = 0; d0 < 4; ++d0) Qf[it][d0] = *(const bf16x8*)(qp + 16 * d0 + 8 * hi); }
    const bool full = chain_ui <= 0; const int par = full ? 0 : (chain_ui & 1);
    const int ph0 = par * 128, ph1 = (par ^ 1) * 128;
    u32x4 kk[4], vv[4];
#pragma unroll
    for (int i = 0; i < 4; ++i) { const int t_ = tid + 512 * (i & 1), krl = t_ >> 3, ch = t_ & 7, h = (i < 2) ? 1 : 0;
        kk[i] = (u32x4){0u, 0u, 0u, 0u};
        if (h == 1 || (full && n > 0)) kk[i] = *(const u32x4*)(Kb + (size_t)(r0 - 128 + h * 128 + krl) * 256 + g * 64 + ch * 8); }
#pragma unroll
    for (int i = 0; i < 4; ++i) { const int t_ = tid + 512 * (i & 1), kvl = t_ & 127, c = t_ >> 7, h = (i < 2) ? 1 : 0;
        vv[i] = (u32x4){0u, 0u, 0u, 0u};
        if (h == 1 || (full && n > 0)) vv[i] = *(const u32x4*)(Vb + (size_t)(r0 - 128 + h * 128 + kvl) * 256 + g * 64 + c * 8); }
#pragma unroll
    for (int i = 0; i < 4; ++i) { const int t_ = tid + 512 * (i & 1), krl = t_ >> 3, ch = t_ & 7, h = (i < 2) ? 1 : 0;
        if (h == 1 || full) *(LAS u32x4*)(lds + KS_OFF + ((h ? ph1 : ph0) + krl) * KS_PITCH + ch * 16) = kk[i]; }
#pragma unroll
    for (int i = 0; i < 4; ++i) { const int t_ = tid + 512 * (i & 1), kvl = t_ & 127, c = t_ >> 7, h = (i < 2) ? 1 : 0;
        if (h == 1 || full) { LAS bf16_t* vp = (LAS bf16_t*)(lds + VS_OFF + (c * 8) * VS_PITCH + ((h ? ph1 : ph0) + kvl) * 2);
#pragma unroll
            for (int e = 0; e < 8; ++e) { const unsigned w = vv[i][e >> 1]; vp[e * (VS_PITCH / 2)] = (bf16_t)((e & 1) ? (w >> 16) : (w & 0xffffu)); } } }
    __syncthreads();
    const int ks = (q & 0x13) | ((q & 4) << 1) | ((q & 8) >> 1);
    const float sink = sinks[head];
#pragma unroll
    for (int it = 0; it < 2; ++it) {
        const int rb = (wid & 1) * 2 + it;
        f32x16 S[5];
#pragma unroll
        for (int j = 0; j < 5; ++j) {
#pragma unroll
            for (int r = 0; r < 16; ++r) S[j][r] = 0.f;
#pragma unroll
            for (int d0 = 0; d0 < 4; ++d0) { const bf16x8 Kf = *(const LAS bf16x8*)(lds + KS_OFF + ((((rb + j) >> 2) ? ph1 : ph0) + ((32 * (rb + j)) & 127) + ks) * KS_PITCH + (16 * d0 + 8 * hi) * 2);
                S[j] = __builtin_amdgcn_mfma_f32_32x32x16_bf16(Kf, Qf[it][d0], S[j], 0, 0, 0); } }
        float mx = -3.0e38f;
#pragma unroll
        for (int j = 0; j < 5; ++j) { const bool tile_ok = (n > 0) || (rb + j >= 4);
#pragma unroll
            for (int r = 0; r < 16; ++r) { const int off = 16 * (r >> 3) + 8 * hi + (r & 7), diff = 128 + q - 32 * j - off;
                bool ok = tile_ok; if (j == 0) ok = ok && (diff < 128); if (j == 4) ok = ok && (diff >= 0);
                const float sv = ok ? S[j][r] * 0.125f : -1e30f; S[j][r] = sv; mx = fmaxf(mx, sv); } }
        mx = fmaxf(mx, __shfl_xor(mx, 32)); mx = fmaxf(mx, sink);
        const float L2E = 1.4426950408889634f, mneg = -mx * L2E;
        float sum = 0.f;
#pragma unroll
        for (int j = 0; j < 5; ++j)
#pragma unroll
            for (int r = 0; r < 16; ++r) { const float pv = __builtin_amdgcn_exp2f(S[j][r] * L2E + mneg); S[j][r] = pv; sum += pv; }
        sum += __shfl_xor(sum, 32);
        const float inv = 1.0f / (sum + __builtin_amdgcn_exp2f((sink - mx) * L2E));
        f32x16 O0, O1;
#pragma unroll
        for (int r = 0; r < 16; ++r) { O0[r] = 0.f; O1[r] = 0.f; }
#pragma unroll
        for (int j = 0; j < 5; ++j)
#pragma unroll
            for (int st = 0; st < 2; ++st) {
                u32x4 pw; pw.x = pg8::cvt_pk_bf16(S[j][8 * st + 0], S[j][8 * st + 1]); pw.y = pg8::cvt_pk_bf16(S[j][8 * st + 2], S[j][8 * st + 3]);
                pw.z = pg8::cvt_pk_bf16(S[j][8 * st + 4], S[j][8 * st + 5]); pw.w = pg8::cvt_pk_bf16(S[j][8 * st + 6], S[j][8 * st + 7]);
                const bf16x8 Pf = __builtin_bit_cast(bf16x8, pw);
                const int kvoff = ((((rb + j) >> 2) ? ph1 : ph0) + ((32 * (rb + j)) & 127) + 16 * st + 8 * hi) * 2;
                const bf16x8 V0 = *(const LAS bf16x8*)(lds + VS_OFF + q * VS_PITCH + kvoff), V1 = *(const LAS bf16x8*)(lds + VS_OFF + (32 + q) * VS_PITCH + kvoff);
                O0 = __builtin_amdgcn_mfma_f32_32x32x16_bf16(V0, Pf, O0, 0, 0, 0); O1 = __builtin_amdgcn_mfma_f32_32x32x16_bf16(V1, Pf, O1, 0, 0, 0); }
        { LAS unsigned char* ost = lds + OS_OFF + wid * OS_WAVE;
#pragma unroll
          for (int r4 = 0; r4 < 4; ++r4) { const int d = 8 * r4 + 4 * hi;
            u32x2 w0, w1; w0.x = pg8::cvt_pk_bf16(O0[4 * r4] * inv, O0[4 * r4 + 1] * inv); w0.y = pg8::cvt_pk_bf16(O0[4 * r4 + 2] * inv, O0[4 * r4 + 3] * inv);
            w1.x = pg8::cvt_pk_bf16(O1[4 * r4] * inv, O1[4 * r4 + 1] * inv); w1.y = pg8::cvt_pk_bf16(O1[4 * r4 + 2] * inv, O1[4 * r4 + 3] * inv);
            *(LAS u32x2*)(ost + q * OS_PITCH + d * 2) = w0; *(LAS u32x2*)(ost + q * OS_PITCH + (32 + d) * 2) = w1; }
          __builtin_amdgcn_wave_barrier(); asm volatile("" ::: "memory");
          bf16_t* ob = O + (size_t)(r0 + 32 * rb) * DM + head * 64;
#pragma unroll
          for (int ps = 0; ps < 4; ++ps) { const int rr = 8 * ps + (lane >> 3), pc = lane & 7;
            const u32x4 v = *(const LAS u32x4*)(ost + rr * OS_PITCH + pc * 16);
            *(u32x4*)(ob + (size_t)rr * DM + pc * 8) = v; }
          __builtin_amdgcn_wave_barrier(); asm volatile("" ::: "memory"); }
    }
    __syncthreads();
}

__device__ __forceinline__ void p10_final(const Args& A, int lane, int wave, float* outp) {
    const float* ssq = (const float*)(A.ws + WS_SSQF); const bf16_t* X3 = (const bf16_t*)(A.ws + WS_X3);
    const int gw = blockIdx.x * 8 + wave, NGW = gridDim.x * 8;
    for (int m = gw; m < M; m += NGW) { const float rs = pg8::rstd_from(ssq, m);
#pragma unroll
        for (int j = 0; j < 2; ++j) { const int c = 8 * lane + 512 * j; f32x4 a, b; pg8::unpack8(*(const u32x4*)(X3 + (size_t)m * DM + c), a, b);
            *(f32x4*)(outp + (size_t)m * DM + c) = (a * rs) * *(const f32x4*)(A.g_final + c); *(f32x4*)(outp + (size_t)m * DM + c + 4) = (b * rs) * *(const f32x4*)(A.g_final + c + 4); } }
}

constexpr int N_PHASES = 11;
__global__ void __launch_bounds__(512, 2) mk_fwd(Args A) {
    extern __shared__ __attribute__((aligned(16))) unsigned char lds_raw[];
    LAS unsigned char* lds = (LAS unsigned char*)lds_raw;
    cg::grid_group grid = cg::this_grid();
    const int tid = threadIdx.x, lane = tid & 63, wave = __builtin_amdgcn_readfirstlane(tid >> 6);
    const int lo = A.ph_lo, hi = A.ph_hi, G = gridDim.x, cid = blockIdx.x;
    unsigned char* ws = A.ws;
    const float* mods = (const float*)(ws + WS_MODS);
    bf16_t* const RES = (bf16_t*)((unsigned char*)A.out + OUT_RES);
#define IN(k) (lo <= (k) && (k) < hi)
    if (tid < 2) ((LAS unsigned*)(lds + LDS_BARW))[tid] = 0u;
    __syncthreads();
    XcdBarrier bar; bar.bar = (unsigned*)(ws + WS_CTL); bar.x = 0; bar.st = nullptr;
    if (hi - lo > 1) bar = xcd_barrier_post((unsigned*)(ws + WS_CTL), (volatile LAS unsigned*)(lds + LDS_BARW));
    if (lo < 0) grid.sync();
#define SEAM(k) do { if (IN(k) && IN((k) + 1)) xcd_barrier(bar); } while (0)
    if (IN(0)) { p0_prologue(A, lds, tid, lane, wave); } SEAM(0);
    if (IN(1)) { p1_rows(A, lane, wave); } SEAM(1);
    if (IN(2)) { pg8::Gemm g{(const bf16_t*)(ws + WS_HB), (const bf16_t*)(ws + WS_W1GU), M, NGU, DM}; pg8::StaticOrder S; S.init(M, NGU, G, cid);
        pg8::EpiGU<false> E{(bf16_t*)(ws + WS_ACT1), nullptr, nullptr, nullptr};
        pg8::gemm_phase<pg8::EpiGU<false>, pg8::StaticOrder, true, true>(lds, g, S, E); } SEAM(2);
    if (IN(3)) { pg8::Gemm g{(const bf16_t*)(ws + WS_ACT1), (const bf16_t*)(ws + WS_W1DN), M, DM, DFF}; pg8::StaticOrder S; S.init(M, DM, G, cid);
        pg8::EpiRes<true, true, false, true> E{A.x, RES, mods + MOD_GT1 * DM, (bf16_t*)(ws + WS_HB), A.g_mix, mods + MOD_SC2 * DM, (float*)(ws + WS_SSQ2), lds + LDS_STG};
        pg8::gemm_phase<pg8::EpiRes<true, true, false, true>, pg8::StaticOrder, true, true>(lds, g, S, E); } SEAM(3);
    if (IN(4)) { pg8::Gemm g{(const bf16_t*)(ws + WS_HB), (const bf16_t*)(ws + WS_WIN), M, DIN, DM}; pg8::StaticOrder S; S.init(M, DIN, G, cid);
        pg8::EpiIn E{lds + LDS_SCR, lds + LDS_STG, (const float*)(ws + WS_SSQ2), (const float*)(ws + WS_BIAS2), (const float*)(ws + WS_COS), (const float*)(ws + WS_SIN),
                     (bf16_t*)(ws + WS_BG), (bf16_t*)(ws + WS_CU), (bf16_t*)(ws + WS_Q), (bf16_t*)(ws + WS_K), (bf16_t*)(ws + WS_V), (bf16_t*)(ws + WS_SZC), (bf16_t*)(ws + WS_SZA)};
        pg8::gemm_phase<pg8::EpiIn, pg8::StaticOrder, true, true>(lds, g, S, E); } SEAM(4);
    if (IN(5)) { int t5 = threadIdx.x; asm volatile("" : "+v"(t5)); const int l5 = t5 & 63;
        p5_conv(A, l5, wave, (bf16_t*)(ws + WS_BG));
        const bool xmap = (G * 4 == BATCH * 4 * (SEQ / 128)) && (G % 8 == 0); const int vcu = xmap ? (cid % 8) * (G / 8) + cid / 8 : cid;
        for (int ui = 0, u = xmap ? 4 * vcu : cid; u < BATCH * 4 * (SEQ / 128) && (!xmap || ui < 4); ++ui, u += xmap ? 1 : G) attn_unit(lds, (const bf16_t*)(ws + WS_Q), (bf16_t*)(ws + WS_Q), (const bf16_t*)(ws + WS_K), (const bf16_t*)(ws + WS_V), A.sinks, u, t5, l5, wave, xmap ? ui : 0); } SEAM(5);
    if (IN(6)) { pg8::Gemm g{(const bf16_t*)(ws + WS_BG), (const bf16_t*)(ws + WS_WC), M, DM, DM, (const bf16_t*)(ws + WS_Q), (const bf16_t*)(ws + WS_WA)}; pg8::DualOrder S; S.init(M, DM, G, cid);
        pg8::EpiDual E{(const bf16_t*)(ws + WS_SZC), (const bf16_t*)(ws + WS_SZA), (bf16_t*)(ws + WS_HB), lds + LDS_STG};
        pg8::gemm_phase<pg8::EpiDual, pg8::DualOrder, true, true>(lds, g, S, E); } SEAM(6);
    if (IN(7)) { pg8::Gemm g{(const bf16_t*)(ws + WS_HB), (const bf16_t*)(ws + WS_WO), M, DM, DM}; pg8::StaticOrder S; S.init(M, DM, G, cid);
        pg8::EpiRes<false, true, true, false> E{RES, RES, mods + MOD_GT2 * DM, (bf16_t*)(ws + WS_BG), A.g_ffn2, mods + MOD_SC3 * DM, (float*)(ws + WS_SSQ3), lds + LDS_STG};
        pg8::gemm_phase<pg8::EpiRes<false, true, true, false>, pg8::StaticOrder, true, true>(lds, g, S, E); } SEAM(7);
    if (IN(8)) { pg8::Gemm g{(const bf16_t*)(ws + WS_BG), (const bf16_t*)(ws + WS_W2GU), M, NGU, DM}; pg8::StaticOrder S; S.init(M, NGU, G, cid);
        pg8::EpiGU<true> E{(bf16_t*)(ws + WS_ACT2), (const float*)(ws + WS_SSQ3), (const float*)(ws + WS_BIAS3), lds + LDS_SCR};
        pg8::gemm_phase<pg8::EpiGU<true>, pg8::StaticOrder, true, true>(lds, g, S, E); } SEAM(8);
    if (IN(9)) { pg8::Gemm g{(const bf16_t*)(ws + WS_ACT2), (const bf16_t*)(ws + WS_W2DN), M, DM, DFF}; pg8::StaticOrder S; S.init(M, DM, G, cid);
        pg8::EpiRes<true, false, true, true> E{RES, (bf16_t*)(ws + WS_X3), mods + MOD_GT3 * DM, nullptr, nullptr, nullptr, (float*)(ws + WS_SSQF), lds + LDS_STG};
        pg8::gemm_phase<pg8::EpiRes<true, false, true, true>, pg8::StaticOrder, true, true>(lds, g, S, E); } SEAM(9);
    if (IN(10)) { int t10 = threadIdx.x; asm volatile("" : "+v"(t10)); p10_final(A, t10 & 63, wave, A.out); }
#undef IN
#undef SEAM
}

#ifndef MK_PER_PHASE
#define MK_PER_PHASE 0
#endif
extern "C" void kernel_launch(void* const* d_in, const int* in_sizes, int n_in, void* d_out, int out_size, void* d_ws, size_t ws_size, hipStream_t stream) {
    static int grid = 0;
    if (grid == 0) {
        if (n_in != 18 || in_sizes[0] != M * DM || out_size != M * DM || ws_size < WS_END) { fprintf(stderr, "kernel_launch: unexpected shapes (n_in %d, in0 %d, out %d, ws %zu); nothing launched\n", n_in, n_in > 0 ? in_sizes[0] : -1, out_size, ws_size); grid = -1; return; }
        int dev = 0, cus = 0, per_cu = 0;
        if (hipGetDevice(&dev) != hipSuccess || hipDeviceGetAttribute(&cus, hipDeviceAttributeMultiprocessorCount, dev) != hipSuccess) { grid = -1; return; }
        if (hipFuncSetAttribute((const void*)mk_fwd, hipFuncAttributeMaxDynamicSharedMemorySize, LDS_BYTES) != hipSuccess) { fprintf(stderr, "kernel_launch: hipFuncSetAttribute failed\n"); grid = -1; return; }
        if (hipOccupancyMaxActiveBlocksPerMultiprocessor(&per_cu, (const void*)mk_fwd, 512, LDS_BYTES) != hipSuccess || per_cu < 1) { fprintf(stderr, "kernel_launch: occupancy query failed (%d)\n", per_cu); (void)hipGetLastError(); per_cu = 1; }
        grid = cus * (per_cu > 1 ? 1 : per_cu);
    }
    if (grid < 0) return;
    if (hipMemsetAsync((char*)d_ws + WS_CTL, 0, CTL_BYTES, stream) != hipSuccess) { fprintf(stderr, "kernel_launch: memset failed\n"); return; }
    Args a{};
    const float** pp = &a.x;
    for (int i = 0; i < 18; ++i) pp[i] = (const float*)d_in[i];
    a.out = (float*)d_out; a.ws = (unsigned char*)d_ws;
    for (int i = 0; i < 32; ++i) { const float e = (float)(2 * i) / 64.0f; a.inv_freq[i] = 1.0f / powf(10000.0f, e); }
    const int nl = MK_PER_PHASE ? N_PHASES : 1;
    for (int li = 0; li < nl; ++li) {
        a.ph_lo = MK_PER_PHASE ? li : 0; a.ph_hi = MK_PER_PHASE ? li + 1 : N_PHASES;
        void* args[] = {&a};
        const hipError_t e = hipLaunchCooperativeKernel((const void*)mk_fwd, dim3(grid), dim3(512), args, LDS_BYTES, stream);
        if (e != hipSuccess) { fprintf(stderr, "kernel_launch: cooperative launch %d failed: %s (grid %d)\n", li, hipGetErrorString(e), grid); break; }
    }
}
```

```cpp
#include <hip/hip_runtime.h>
#include <hip/hip_cooperative_groups.h>
#include <cstdio>
#include <cstdint>
#include <cmath>
namespace cg = cooperative_groups;
namespace pg8 {
#define PG8_LAS __attribute__((address_space(3)))
typedef unsigned short bf16_t;
typedef short bf16x8 __attribute__((ext_vector_type(8)));
typedef float f32x4 __attribute__((ext_vector_type(4)));
typedef unsigned u32x4 __attribute__((ext_vector_type(4)));
constexpr int BM = 256, BK = 64, HALF = 128, HTB = HALF * BK * 2  , STAGE_BYTES = 8 * HTB, NXCD = 8, WGM = 2;

__host__ __device__ __forceinline__ int lds_byte(int r, int c) { const int st = (r >> 4) * 2 + (c >> 5), rr = r & 15, cc = c & 31, ob = rr * 64 + cc * 2; return st * 1024 + (ob ^ (((ob >> 9) & 1) << 5)); }
__host__ __device__ __forceinline__ void stage_rc(int b, int& R, int& C) { const int st = b / 1024, sb = b % 1024, swz = sb ^ (((sb >> 9) & 1) << 5); R = (st >> 1) * 16 + swz / 64; C = (st & 1) * 32 + (swz % 64) / 2; }
__host__ __device__ __forceinline__ int perm32(int rho) { const int n = rho >> 4, i = rho & 15; return 8 * (i >> 2) + 4 * n + (i & 3); }

struct Unit { int pm, pn, sel; };
struct Gemm { const bf16_t* A; const bf16_t* Bt; int M, N, K; const bf16_t* A2; const bf16_t* Bt2; };

struct StaticOrder {
    int nM, nN, nwg, G, c;
    __host__ __device__ void init(int M, int N, int G_, int c_) { nM = M / BM; nN = N / BM; nwg = nM * nN; G = G_; c = c_; }
    __host__ __device__ bool next(int i, Unit& u) const {
        const long L = (long)i * G + c; if (L >= nwg) return false;
        int wgid = (int)L; { const int q = nwg / NXCD, r = nwg % NXCD, xcd = wgid % NXCD, off = wgid / NXCD; wgid = (xcd < r ? xcd * (q + 1) : r * (q + 1) + (xcd - r) * q) + off; }
        const int nig = WGM * nN, gid = wgid / nig, fm = gid * WGM, gsz = (nM - fm) < WGM ? (nM - fm) : WGM;
        u.pm = fm + ((wgid % nig) % gsz); u.pn = (wgid % nig) / gsz; u.sel = 0; return true;
    }
    __device__ __forceinline__ void a_ready(const Unit&) const {}
    __device__ __forceinline__ void done(const Unit&) const {}
};

struct DualOrder {
    StaticOrder b;
    __host__ __device__ void init(int M, int N, int G_, int c_) { b.init(M, N, G_, c_); }
    __host__ __device__ bool next(int i, Unit& u) const { if (!b.next(i >> 1, u)) return false; u.sel = i & 1; return true; }
    __device__ __forceinline__ void a_ready(const Unit&) const {}
    __device__ __forceinline__ void done(const Unit&) const {}
};
__device__ __forceinline__ unsigned cvt_pk_bf16(float lo, float hi) { unsigned r; asm volatile("v_cvt_pk_bf16_f32 %0, %1, %2" : "=v"(r) : "v"(lo), "v"(hi)); return r; }
typedef float f32x2 __attribute__((ext_vector_type(2)));
template <class Epi, class Sched, bool ALIGN_EPI = false, bool SP2 = false>
__device__ __forceinline__ void gemm_phase(PG8_LAS unsigned char* lds, const Gemm g, const Sched& S, const Epi& E) {
    const int tid = threadIdx.x, wid = __builtin_amdgcn_readfirstlane(tid >> 6), lane = tid & 63, wr = wid >> 2, wc = wid & 3, fr = lane & 15, fq = lane >> 4;
    const int K = g.K, nt = K / BK;
    unsigned voffA[2], voffB[2];
#pragma unroll
    for (int i = 0; i < 2; ++i) { int R, C; stage_rc(tid * 16 + i * 8192, R, C); const int Rb = Epi::PERM ? ((R & ~31) + perm32(R & 31)) : R;
        voffA[i] = Epi::AIL ? (unsigned)((R >> 1) * (2 * K) + (C >> 5) * 64 + (R & 1) * 32 + (C & 31)) * 2u : (unsigned)(R * K + C) * 2u; voffB[i] = (unsigned)(Rb * K + C) * 2u; }
    const size_t kstep = (size_t)(BK * 2);
    const size_t kstepA = Epi::AIL ? (size_t)(BK * 4) : kstep;
    const size_t hstep = (size_t)HALF * K * 2;
    const size_t tstep = 2 * hstep;
    const unsigned ldsw = (unsigned)wid * 1024u;
    const int aoff = lds_byte(wr * 64 + fr, fq * 8), boff = lds_byte(wc * 32 + fr, fq * 8);
#define PG8_ABASE(u) ((const char*)((Epi::DUAL && (u).sel) ? g.A2 : g.A) + (size_t)(u).pm * tstep)
#define PG8_BBASE(u) ((const char*)((Epi::DUAL && (u).sel) ? g.Bt2 : g.Bt) + (size_t)(u).pn * tstep)
#define PG8_SA(b, h) (((b) * 2 + (h)) * HTB)
#define PG8_SB(b, h) ((4 + (b) * 2 + (h)) * HTB)
#define PG8_STAGE(bufoff, gbase, voff) do { _Pragma("unroll") for (int _i = 0; _i < 2; ++_i) \
        __builtin_amdgcn_global_load_lds((const unsigned*)((const char*)(gbase) + (voff)[_i]), (PG8_LAS unsigned*)(lds + (bufoff) + ldsw + _i * 8192), 16, 0, 0); } while (0)
#define PG8_LDA(dst, b, h) do { _Pragma("unroll") for (int m = 0; m < 4; ++m) _Pragma("unroll") for (int k = 0; k < 2; ++k) dst[m][k] = *(const PG8_LAS bf16x8*)(lds + PG8_SA(b, h) + aoff + m * 2048 + k * 1024); } while (0)
#define PG8_LDB(dst, b, h) do { _Pragma("unroll") for (int n = 0; n < 2; ++n) _Pragma("unroll") for (int k = 0; k < 2; ++k) dst[n][k] = *(const PG8_LAS bf16x8*)(lds + PG8_SB(b, h) + boff + n * 2048 + k * 1024); } while (0)
#define PG8_MMA(ai, bj, At, Bt) do { __builtin_amdgcn_s_setprio(1); _Pragma("unroll") for (int m = 0; m < 4; ++m) _Pragma("unroll") for (int n = 0; n < 2; ++n) _Pragma("unroll") for (int k = 0; k < 2; ++k) \
        acc[ai][bj][m][n] = __builtin_amdgcn_mfma_f32_16x16x32_bf16(Bt[n][k], At[m][k], acc[ai][bj][m][n], 0, 0, 0); __builtin_amdgcn_s_setprio(0); } while (0)
#define PG8_WAIT_V(n) asm volatile("s_waitcnt vmcnt(" #n ")" ::: "memory")
#define PG8_WAIT_L(n) asm volatile("s_waitcnt lgkmcnt(" #n ")" ::: "memory")
#define PG8_BAR __builtin_amdgcn_s_barrier()
#define PG8_SCHED __builtin_amdgcn_sched_barrier(0)
    Unit cur, nxt; int ui = 0;
    int tpf = 0; asm volatile("" : "+s"(tpf));
    if (!S.next(0, cur)) return;
    f32x4 acc[2][2][4][2];
#pragma unroll
    for (int a = 0; a < 2; ++a)
#pragma unroll
        for (int b = 0; b < 2; ++b)
#pragma unroll
            for (int m = 0; m < 4; ++m)
#pragma unroll
                for (int n = 0; n < 2; ++n) acc[a][b][m][n] = (f32x4){0.f, 0.f, 0.f, 0.f};
    bf16x8 At[4][2], B0[2][2], B1[2][2];
    const char* cA = PG8_ABASE(cur); const char* cB = PG8_BBASE(cur);
    S.a_ready(cur);
    if constexpr (SP2) {
        PG8_STAGE(PG8_SB(0, 0), cB, voffB); PG8_STAGE(PG8_SB(0, 1), cB + hstep, voffB); PG8_STAGE(PG8_SA(0, 0), cA, voffA); PG8_STAGE(PG8_SA(0, 1), cA + hstep, voffA);
        if (wr == 1) PG8_BAR;
        PG8_WAIT_V(2); PG8_BAR;
        PG8_STAGE(PG8_SB(1, 0), cB + kstep, voffB); PG8_STAGE(PG8_SA(1, 0), cA + kstepA, voffA); PG8_STAGE(PG8_SB(1, 1), cB + hstep + kstep, voffB);
        PG8_WAIT_V(6); PG8_BAR;
    } else {
        PG8_STAGE(PG8_SB(0, 0), cB, voffB); PG8_STAGE(PG8_SA(0, 0), cA, voffA); PG8_STAGE(PG8_SB(0, 1), cB + hstep, voffB); PG8_STAGE(PG8_SA(0, 1), cA + hstep, voffA);
        if (wr == 1) PG8_BAR;
        PG8_WAIT_V(4); PG8_BAR;
        PG8_STAGE(PG8_SB(1, 0), cB + kstep, voffB); PG8_STAGE(PG8_SA(1, 0), cA + kstepA, voffA); PG8_STAGE(PG8_SB(1, 1), cB + hstep + kstep, voffB);
        PG8_WAIT_V(6); PG8_BAR;
    }
    for (;;) {
        const bool has_next = S.next(ui + 1, nxt);
        const char* nA = has_next ? PG8_ABASE(nxt) : cA; const char* nB = has_next ? PG8_BBASE(nxt) : cB;
        for (int t = 0; t < nt; t += 2) {
            const bool last = (t == nt - 2);
            const char* a1 = cA + (size_t)(t + 1) * kstepA;
            const char* a2 = last ? nA : cA + (size_t)(t + 2) * kstepA; const char* b2 = last ? nB : cB + (size_t)(t + 2) * kstep;
            const char* a3 = a2 + kstepA; const char* b3 = b2 + kstep;
            if (last && has_next) S.a_ready(nxt);
            if constexpr (SP2) {
            PG8_LDB(B0, 0, 0); PG8_LDB(B1, 0, 1); PG8_SCHED; PG8_LDA(At, 0, 0); PG8_STAGE(PG8_SA(1, 1), a1 + hstep, voffA);
            PG8_WAIT_V(8); PG8_WAIT_L(0); PG8_BAR; PG8_MMA(0, 0, At, B0); PG8_MMA(0, 1, At, B1); PG8_BAR; PG8_SCHED;
            if constexpr (Epi::PREFETCH) { if (t == tpf) E.prefetch(cur, wid, lane); }
            PG8_LDA(At, 0, 1); PG8_STAGE(PG8_SB(0, 0), b2, voffB); PG8_STAGE(PG8_SB(0, 1), b2 + hstep, voffB); PG8_STAGE(PG8_SA(0, 0), a2, voffA);
            PG8_WAIT_V(8); PG8_WAIT_L(0); PG8_BAR; PG8_MMA(1, 0, At, B0); PG8_MMA(1, 1, At, B1); PG8_BAR; PG8_SCHED;
            PG8_LDB(B0, 1, 0); PG8_LDB(B1, 1, 1); PG8_SCHED; PG8_LDA(At, 1, 0); PG8_STAGE(PG8_SA(0, 1), a2 + hstep, voffA);
            PG8_WAIT_V(8); PG8_WAIT_L(0); PG8_BAR; PG8_MMA(0, 0, At, B0); PG8_MMA(0, 1, At, B1); PG8_BAR; PG8_SCHED;
            PG8_LDA(At, 1, 1); PG8_STAGE(PG8_SB(1, 0), b3, voffB); PG8_STAGE(PG8_SB(1, 1), b3 + hstep, voffB); PG8_STAGE(PG8_SA(1, 0), a3, voffA);
            PG8_WAIT_V(8); PG8_WAIT_L(0); PG8_BAR; PG8_MMA(1, 0, At, B0); PG8_MMA(1, 1, At, B1); PG8_BAR; PG8_SCHED;
            } else {
            PG8_LDB(B0, 0, 0); PG8_SCHED; PG8_LDA(At, 0, 0); PG8_STAGE(PG8_SA(1, 1), a1 + hstep, voffA);
            PG8_WAIT_L(8); PG8_BAR; PG8_WAIT_L(0); PG8_MMA(0, 0, At, B0); PG8_BAR; PG8_SCHED;
            PG8_LDB(B1, 0, 1); PG8_STAGE(PG8_SB(0, 0), b2, voffB);
            PG8_BAR; PG8_WAIT_L(0); PG8_MMA(0, 1, At, B1); PG8_BAR;
            PG8_LDA(At, 0, 1); PG8_STAGE(PG8_SA(0, 0), a2, voffA);
            PG8_BAR; PG8_WAIT_L(0); PG8_MMA(1, 0, At, B0); PG8_BAR; PG8_SCHED;
            PG8_STAGE(PG8_SB(0, 1), b2 + hstep, voffB);
            PG8_WAIT_V(6); PG8_BAR; PG8_MMA(1, 1, At, B1); PG8_BAR;
            PG8_LDB(B0, 1, 0); PG8_SCHED; PG8_LDA(At, 1, 0); PG8_STAGE(PG8_SA(0, 1), a2 + hstep, voffA);
            PG8_WAIT_L(8); PG8_BAR; PG8_WAIT_L(0); PG8_MMA(0, 0, At, B0); PG8_BAR; PG8_SCHED;
            PG8_LDB(B1, 1, 1); PG8_STAGE(PG8_SB(1, 0), b3, voffB);
            PG8_BAR; PG8_WAIT_L(0); PG8_MMA(0, 1, At, B1); PG8_BAR;
            PG8_LDA(At, 1, 1); PG8_STAGE(PG8_SA(1, 0), a3, voffA);
            PG8_BAR; PG8_WAIT_L(0); PG8_MMA(1, 0, At, B0); PG8_BAR; PG8_SCHED;
            PG8_STAGE(PG8_SB(1, 1), b3 + hstep, voffB);
            PG8_WAIT_V(6); PG8_BAR; PG8_MMA(1, 1, At, B1); PG8_BAR;
            }
        }
        if constexpr (ALIGN_EPI) { if (wr == 0) PG8_BAR; }
        if constexpr (!Epi::AFTER_DRAIN) { if constexpr (Epi::DUAL) { if (cur.sel == 0) E.mid(acc, cur, wr, wc, fr, fq); else E(acc, cur, wr, wc, fr, fq); } else { E(acc, cur, wr, wc, fr, fq); } S.done(cur); }
        if (!has_next) break;
        if (!(Epi::DUAL && cur.sel == 0))
#pragma unroll
        for (int a = 0; a < 2; ++a)
#pragma unroll
            for (int b = 0; b < 2; ++b)
#pragma unroll
                for (int m = 0; m < 4; ++m)
#pragma unroll
                    for (int n = 0; n < 2; ++n) acc[a][b][m][n] = (f32x4){0.f, 0.f, 0.f, 0.f};
        cur = nxt; cA = nA; cB = nB; ++ui;
        if constexpr (ALIGN_EPI) { if (wr == 1) PG8_BAR; }
    }
    PG8_WAIT_V(0);
    if constexpr (!ALIGN_EPI) { if (wr == 0) PG8_BAR; }
    PG8_BAR;
    if constexpr (Epi::AFTER_DRAIN) { E.fused(acc, cur, wr, wc, fr, fq, lds, wid, lane); S.done(cur); }
#undef PG8_SA
#undef PG8_ABASE
#undef PG8_BBASE
#undef PG8_SB
#undef PG8_STAGE
#undef PG8_LDA
#undef PG8_LDB
#undef PG8_MMA
#undef PG8_WAIT_V
#undef PG8_WAIT_L
#undef PG8_BAR
#undef PG8_SCHED
}
}

constexpr int BATCH = 4, SEQ = 8192, DM = 1024, M = BATCH * SEQ, DFF = 2816, NGU = 2 * DFF, DIN = 6656, NMODC = 9 * DM;
constexpr float RMS_EPS = 1e-6f;
enum { MOD_SH1 = 0, MOD_SC1, MOD_GT1, MOD_SH2, MOD_SC2, MOD_GT2, MOD_SH3, MOD_SC3, MOD_GT3 };

constexpr size_t MiB = 1u << 20;
constexpr size_t WS_MODS = 0, WS_BIAS2 = 256 * 1024, WS_BIAS3 = 384 * 1024, WS_CTL = 512 * 1024  , CTL_BYTES = 16384, WS_COS = 1 * MiB, WS_SIN = 2 * MiB;
constexpr size_t WS_SSQ2 = 3 * MiB, WS_SSQ3 = 5 * MiB, WS_SSQF = 7 * MiB;
constexpr size_t WS_W1GU = 9 * MiB, WS_W1DN = 20 * MiB, WS_WIN = 26 * MiB, WS_WC = 39 * MiB, WS_WA = 41 * MiB, WS_WO = 43 * MiB, WS_W2GU = 45 * MiB, WS_W2DN = 56 * MiB;
constexpr size_t WS_HB = 64 * MiB;
constexpr size_t WS_BG = 128 * MiB;
constexpr size_t WS_Q = 192 * MiB;
constexpr size_t WS_SZC = 256 * MiB, WS_SZA = 320 * MiB;
constexpr size_t WS_CU = 384 * MiB;
constexpr size_t WS_K = 448 * MiB, WS_V = 464 * MiB;
constexpr size_t WS_PART = 384 * MiB;
constexpr size_t WS_ACT1 = 128 * MiB, WS_ACT2 = 192 * MiB;
constexpr size_t WS_X3 = 128 * MiB;
constexpr size_t OUT_RES = 64 * MiB;
constexpr size_t WS_END = 512 * MiB;
static_assert(WS_W2DN + (size_t)DM * DFF * 2 <= WS_HB && WS_ACT2 + (size_t)M * DFF * 2 <= WS_PART, "ws map");

#define LAS __attribute__((address_space(3)))
constexpr int LDS_SCR = 131072, LDS_BARW = LDS_SCR + 17408, LDS_STG = LDS_BARW + 256, LDS_BYTES = LDS_STG + 8192;

struct Args {
    const float *x, *c, *w_ada, *b_ada, *g_ffn1, *w1_gu, *w1_down, *g_mix, *w_in, *conv_w, *w_conv_proj, *w_attn_proj, *sinks, *w_out, *g_ffn2, *w2_gu, *w2_down, *g_final;
    float* out; unsigned char* ws; float inv_freq[32]; int ph_lo, ph_hi;
};
#define XB_TMO      128
#define XB_XCNT(j)  (256  + 64 * (j))
#define XB_XSUB(j)  (1280 + 64 * (j))
#define XB_XGEN(j)  (2304 + 64 * (j))
#define XB_TOP      3328
#define XB_TOPGEN   3392
#define XCD_BAR_WORDS 3456
#define XB_SPIN_CAP (1u << 18)

__device__ __forceinline__ unsigned xb_ld(unsigned* p)              { return __hip_atomic_load(p, __ATOMIC_RELAXED, __HIP_MEMORY_SCOPE_AGENT); }
__device__ __forceinline__ unsigned xb_add(unsigned* p, unsigned v) { return __hip_atomic_fetch_add(p, v, __ATOMIC_RELAXED, __HIP_MEMORY_SCOPE_AGENT); }
__device__ __forceinline__ unsigned xb_xcc_id() { return (unsigned)__builtin_amdgcn_s_getreg((3 << 11) | 20) & 0xFu; }
#define XB_SPIN(cond, bar) do { unsigned _sp = 0; while (cond) { __builtin_amdgcn_s_sleep(1); \
    if ((++_sp & 255u) == 0u) { if (xb_ld(&(bar)[XB_TMO])) break; if (_sp > XB_SPIN_CAP) { atomicAdd(&(bar)[XB_TMO], 1u); break; } } } } while (0)

struct XcdBarrier {
    unsigned* bar; unsigned x;
    volatile LAS unsigned* st;
};

__device__ __forceinline__ XcdBarrier xcd_barrier_post(unsigned* bar, volatile LAS unsigned* st) {
    XcdBarrier b; b.bar = bar; b.x = xb_xcc_id(); b.st = st;
    if (threadIdx.x == 0) (void)xb_add(&bar[XB_XCNT(b.x)], 1u);
    return b;
}
__device__ __forceinline__ void xcd_barrier_complete(unsigned* bar, unsigned x, unsigned& nloc, unsigned& nx) {
    const unsigned G = gridDim.x * gridDim.y * gridDim.z;
    unsigned sum, cnt, mine, sp = 0u;
    for (;;) {
        sum = 0u; cnt = 0u; mine = 0u;
#pragma unroll
        for (unsigned j = 0; j < 16; ++j) { const unsigned c = xb_ld(&bar[XB_XCNT(j)]); sum += c; cnt += (c > 0u) ? 1u : 0u; mine = (j == x) ? c : mine; }
        if (sum == G) break;
        __builtin_amdgcn_s_sleep(1);
        if ((++sp & 255u) == 0u) { if (xb_ld(&bar[XB_TMO])) break; if (sp > XB_SPIN_CAP) { atomicAdd(&bar[XB_TMO], 1u); break; } }
    }
    nloc = mine > 0u ? mine : 1u; nx = cnt > 0u ? cnt : 1u;
}

__device__ __forceinline__ void xcd_barrier(const XcdBarrier& b) {
    asm volatile("s_waitcnt vmcnt(0)" ::: "memory");
    __syncthreads();
    if (threadIdx.x == 0) {
        unsigned* bar = b.bar;
        __builtin_amdgcn_s_waitcnt(0);
        unsigned nloc = b.st[0], nx = b.st[1];
        if (nloc == 0u) { xcd_barrier_complete(bar, b.x, nloc, nx); b.st[0] = nloc; b.st[1] = nx; }
        const unsigned old = xb_add(&bar[XB_XSUB(b.x)], 1u);
        const unsigned gen = old / nloc;
        if (old + 1u == (gen + 1u) * nloc) {
            __builtin_amdgcn_fence(__ATOMIC_RELEASE, "agent");
            asm volatile("s_waitcnt vmcnt(0)" ::: "memory");
            const unsigned og = xb_add(&bar[XB_TOP], 1u);
            const unsigned tg = og / nx;
            if (og + 1u == (tg + 1u) * nx) xb_add(&bar[XB_TOPGEN], 1u);
            else XB_SPIN(xb_ld(&bar[XB_TOPGEN]) == tg, bar);
            __builtin_amdgcn_fence(__ATOMIC_ACQUIRE, "agent");
            xb_add(&bar[XB_XGEN(b.x)], 1u);
            asm volatile("s_waitcnt vmcnt(0)" ::: "memory");
        } else {
            XB_SPIN(xb_ld(&bar[XB_XGEN(b.x)]) == gen, bar);
            __builtin_amdgcn_fence(__ATOMIC_ACQUIRE, "agent");
            asm volatile("s_waitcnt vmcnt(0)" ::: "memory");
        }
    }
    __syncthreads();
}

namespace pg8 {
typedef unsigned u32x2 __attribute__((ext_vector_type(2)));
typedef float f32x16 __attribute__((ext_vector_type(16)));
__device__ __forceinline__ u32x4 pack8(const f32x4 a, const f32x4 b) { u32x4 w; w.x = cvt_pk_bf16(a[0], a[1]); w.y = cvt_pk_bf16(a[2], a[3]); w.z = cvt_pk_bf16(b[0], b[1]); w.w = cvt_pk_bf16(b[2], b[3]); return w; }
__device__ __forceinline__ void unpack8(const u32x4 w, f32x4& a, f32x4& b) {
    a[0] = __uint_as_float(w.x << 16); a[1] = __uint_as_float(w.x & 0xffff0000u); a[2] = __uint_as_float(w.y << 16); a[3] = __uint_as_float(w.y & 0xffff0000u);
    b[0] = __uint_as_float(w.z << 16); b[1] = __uint_as_float(w.z & 0xffff0000u); b[2] = __uint_as_float(w.w << 16); b[3] = __uint_as_float(w.w & 0xffff0000u);
}
__device__ __forceinline__ float sigm(float v) { return __builtin_amdgcn_rcpf(1.f + __expf(-v)); }
__device__ __forceinline__ float rstd_from(const float* ssq, int row) {
    const f32x4* p = (const f32x4*)(ssq + (size_t)row * 16);
    const f32x4 s = (p[0] + p[1]) + (p[2] + p[3]);
    return __builtin_amdgcn_rsqf(((s[0] + s[1]) + (s[2] + s[3])) * (1.0f / DM) + RMS_EPS);
}
constexpr int EPI_SCR_BYTES = 17408;
__device__ __forceinline__ void epi_prefetch(PG8_LAS unsigned char* scr, const float* ssq, const float* bias_tile, const Unit& u, int wid, int lane) {
    unsigned lo = (unsigned)lane * 16u; asm volatile("" : "+v"(lo));
    const char* src = (const char*)(ssq + (size_t)u.pm * BM * 16 + wid * 512);
#pragma unroll
    for (int j = 0; j < 2; ++j) __builtin_amdgcn_global_load_lds((const unsigned*)(src + j * 1024 + lo), (PG8_LAS unsigned*)(scr + (wid * 2 + j) * 1024), 16, 0, 0);
    if (wid == 0) __builtin_amdgcn_global_load_lds((const unsigned*)((const char*)bias_tile + lo), (PG8_LAS unsigned*)(scr + 16384), 16, 0, 0);
}
__device__ __forceinline__ float rstd_lds(const PG8_LAS unsigned char* scr, int lrow) {
    const PG8_LAS f32x4* p = (const PG8_LAS f32x4*)(scr + lrow * 64);
    const f32x4 s = (p[0] + p[1]) + (p[2] + p[3]);
    return __builtin_amdgcn_rsqf(((s[0] + s[1]) + (s[2] + s[3])) * (1.0f / DM) + RMS_EPS);
}
#define EPI_LROW (ai * HALF + wr * 64 + m * 16 + fr)
__device__ __forceinline__ void store_lines(PG8_LAS unsigned char* stg, const u32x4 P0, const u32x4 P1, int fr, int fq, bf16_t* seg0, int pitch) {
    const int ln = fq * 16 + fr;
#pragma unroll
    for (int h = 0; h < 2; ++h) {
        if ((fr >> 3) == h) { *(PG8_LAS u32x4*)(stg + (fr & 7) * 128 + fq * 16) = P0; *(PG8_LAS u32x4*)(stg + (fr & 7) * 128 + 64 + fq * 16) = P1; }
        __builtin_amdgcn_wave_barrier(); asm volatile("" ::: "memory");
        const u32x4 v = *(const PG8_LAS u32x4*)(stg + ln * 16);
        __builtin_amdgcn_wave_barrier(); asm volatile("" ::: "memory");
        *(u32x4*)(seg0 + (size_t)(8 * h + (ln >> 3)) * pitch + (ln & 7) * 8) = v; }
}
#define EPI_ROWS _Pragma("unroll") for (int ai = 0; ai < 2; ++ai) _Pragma("unroll") for (int m = 0; m < 4; ++m)
#define EPI_ROW (u.pm * BM + ai * HALF + wr * 64 + m * 16 + fr)

template <bool NORM> struct EpiGU {
    static constexpr bool PERM = true, AFTER_DRAIN = false, DUAL = false, PREFETCH = NORM, AIL = false; static constexpr int EPI_VM = 8;
    bf16_t* act; const float* ssq; const float* bias; PG8_LAS unsigned char* scr;
    __device__ __forceinline__ void prefetch(const Unit& u, int wid, int lane) const { epi_prefetch(scr, ssq, bias + (size_t)(u.pm >> 5) * NGU + u.pn * BM, u, wid, lane); }
    __device__ __forceinline__ void operator()(const f32x4 (&acc)[2][2][4][2], const Unit& u, int wr, int wc, int fr, int fq) const {
        asm volatile("" : "+v"(fr), "+v"(fq));
        const int b = u.pm >> 5, tcol = wc * 32 + fq * 8;
        f32x4 ba0 = {0.f, 0.f, 0.f, 0.f}, ba1 = ba0, bb0 = ba0, bb1 = ba0;
        if (NORM) { const PG8_LAS float* bp = (const PG8_LAS float*)(scr + 16384) + tcol; ba0 = *(const PG8_LAS f32x4*)bp; ba1 = *(const PG8_LAS f32x4*)(bp + 4); bb0 = *(const PG8_LAS f32x4*)(bp + HALF); bb1 = *(const PG8_LAS f32x4*)(bp + HALF + 4); }
        float rsv[2][4];
        if (NORM) { EPI_ROWS { rsv[ai][m] = rstd_lds(scr, EPI_LROW); asm volatile("" : "+v"(rsv[ai][m]) :: "memory"); } }
        EPI_ROWS { const int row = EPI_ROW;
            f32x4 a0 = acc[ai][0][m][0], a1 = acc[ai][0][m][1], b0 = acc[ai][1][m][0], b1 = acc[ai][1][m][1];
            if (NORM) { const float rs = rsv[ai][m]; a0 = a0 * rs + ba0; a1 = a1 * rs + ba1; b0 = b0 * rs + bb0; b1 = b1 * rs + bb1; }
            f32x4 o0, o1;
#pragma unroll
            for (int i = 0; i < 4; ++i) { o0[i] = a0[i] * sigm(a0[i]) * b0[i]; o1[i] = a1[i] * sigm(a1[i]) * b1[i]; }
            *(u32x4*)(act + (size_t)(row >> 1) * (2 * DFF) + (u.pn * 4 + wc) * 64 + (row & 1) * 32 + fq * 8) = pack8(o0, o1); }
    }
};

template <bool HALFG, bool XS, bool XOLD16, bool AIL_> struct EpiRes {
    static constexpr bool PERM = true, AFTER_DRAIN = false, DUAL = false, PREFETCH = false, AIL = AIL_;
    const void* xold; bf16_t* xnew; const float* gate; bf16_t* xs; const float* gcol; const float* scm; float* ssq; PG8_LAS unsigned char* stg;
    __device__ __forceinline__ void operator()(const f32x4 (&acc)[2][2][4][2], const Unit& u, int wr, int wc, int fr, int fq) const {
        asm volatile("" : "+v"(fr), "+v"(fq));
        const int b = u.pm >> 5, col0 = u.pn * BM + wc * 64 + fq * 8;
        PG8_LAS unsigned char* st = stg + (wr * 4 + wc) * 1024;
        f32x4 gv[2][2], cs[2][2];
#pragma unroll
        for (int bj = 0; bj < 2; ++bj)
#pragma unroll
            for (int n = 0; n < 2; ++n) { const int c = col0 + bj * 32 + 4 * n; gv[bj][n] = *(const f32x4*)(gate + (size_t)b * NMODC + c) * (HALFG ? 0.5f : 1.0f);
                cs[bj][n] = (f32x4){0.f, 0.f, 0.f, 0.f}; if (XS) cs[bj][n] = *(const f32x4*)(gcol + c) * (*(const f32x4*)(scm + (size_t)b * NMODC + c) + 1.0f); }
        u32x4 c16[2], n16[2]; f32x4 c32[2][2], n32[2][2];
#define RES_LOAD(D16, D32, r_) do { const size_t ro_ = (size_t)(u.pm * BM + ((r_) >> 2) * HALF + wr * 64 + ((r_) & 3) * 16 + fr) * DM + col0; _Pragma("unroll") for (int bj = 0; bj < 2; ++bj) { \
            if (XOLD16) D16[bj] = *(const u32x4*)((const bf16_t*)xold + ro_ + bj * 32); else { D32[bj][0] = *(const f32x4*)((const float*)xold + ro_ + bj * 32); D32[bj][1] = *(const f32x4*)((const float*)xold + ro_ + bj * 32 + 4); } } } while (0)
        RES_LOAD(c16, c32, 0);
#pragma unroll
        for (int r = 0; r < 8; ++r) { const int ai = r >> 2, m = r & 3; const int row = EPI_ROW; float sq = 0.f;
            if (r < 7) RES_LOAD(n16, n32, r + 1);
            u32x4 pn_[2], ps_[2];
#pragma unroll
            for (int bj = 0; bj < 2; ++bj) {
                f32x4 o0, o1;
                if (XOLD16) unpack8(c16[bj], o0, o1); else { o0 = c32[bj][0]; o1 = c32[bj][1]; }
                const f32x4 v0 = o0 + gv[bj][0] * acc[ai][bj][m][0], v1 = o1 + gv[bj][1] * acc[ai][bj][m][1];
                pn_[bj] = pack8(v0, v1);
                sq += ((v0[0] * v0[0] + v0[1] * v0[1]) + (v0[2] * v0[2] + v0[3] * v0[3])) + ((v1[0] * v1[0] + v1[1] * v1[1]) + (v1[2] * v1[2] + v1[3] * v1[3]));
                if (XS) ps_[bj] = pack8(v0 * cs[bj][0], v1 * cs[bj][1]); }
            { const size_t seg = (size_t)(row - fr) * DM + u.pn * BM + wc * 64;
              store_lines(st, pn_[0], pn_[1], fr, fq, xnew + seg, DM);
              if (XS) store_lines(st, ps_[0], ps_[1], fr, fq, xs + seg, DM); }
            sq += __shfl_xor(sq, 16); sq += __shfl_xor(sq, 32);
            if (fq == 0) ssq[(size_t)row * 16 + u.pn * 4 + wc] = sq;
#pragma unroll
            for (int bj = 0; bj < 2; ++bj) { c16[bj] = n16[bj]; c32[bj][0] = n32[bj][0]; c32[bj][1] = n32[bj][1]; } }
#undef RES_LOAD
    }
};

struct EpiIn {
    static constexpr bool PERM = true, AFTER_DRAIN = false, DUAL = false, PREFETCH = true, AIL = false; static constexpr int EPI_VM = 8;
    PG8_LAS unsigned char* scr; PG8_LAS unsigned char* stg;
    __device__ __forceinline__ void prefetch(const Unit& u, int wid, int lane) const { epi_prefetch(scr, ssq, bias + (size_t)(u.pm >> 5) * DIN + u.pn * BM, u, wid, lane); }
    const float* ssq; const float* bias; const float* cosT; const float* sinT; bf16_t *BG, *CU, *Q, *K, *V, *SZC, *SZA;
    __device__ __forceinline__ void operator()(const f32x4 (&acc)[2][2][4][2], const Unit& u, int wr, int wc, int fr, int fq) const {
        asm volatile("" : "+v"(fr), "+v"(fq));
        const int b = u.pm >> 5, tcol = wc * 32 + fq * 8, pn = u.pn;
        const PG8_LAS float* bp = (const PG8_LAS float*)(scr + 16384) + tcol;
        const f32x4 ba0 = *(const PG8_LAS f32x4*)bp, ba1 = *(const PG8_LAS f32x4*)(bp + 4), bb0 = *(const PG8_LAS f32x4*)(bp + HALF), bb1 = *(const PG8_LAS f32x4*)(bp + HALF + 4);
        int mode, pitch, c0, c1; bf16_t* dst;
        if (pn < 4)       { mode = 0; dst = BG;  pitch = DM;  c0 = pn * BM + wc * 64 + fq * 8; c1 = c0 + 32; }
        else if (pn < 12) { mode = 1; dst = CU;  pitch = DM;  c0 = (pn - 4) * HALF + tcol; c1 = c0; }
        else if (pn < 16) { mode = 2; dst = Q;   pitch = DM;  c0 = (4 * (pn - 12) + wc) * 64 + fq * 8; c1 = c0 + 32; }
        else if (pn < 17) { mode = 2; dst = K;   pitch = 256; c0 = wc * 64 + fq * 8; c1 = c0 + 32; }
        else if (pn < 18) { mode = 0; dst = V;   pitch = 256; c0 = wc * 64 + fq * 8; c1 = c0 + 32; }
        else              { mode = 3; dst = SZC; pitch = DM;  c0 = (pn - 18) * HALF + tcol; c1 = c0; }
        float rsv[2][4];
        EPI_ROWS { rsv[ai][m] = rstd_lds(scr, EPI_LROW); asm volatile("" : "+v"(rsv[ai][m]) :: "memory"); }
#define ROPE_LOAD(C0, C1, S0, S1, r_) do { const int pos_ = (u.pm * BM + ((r_) >> 2) * HALF + wr * 64 + ((r_) & 3) * 16 + fr) & (SEQ - 1); const float* cp_ = cosT + pos_ * 32 + fq * 8; const float* sp_ = sinT + pos_ * 32 + fq * 8; \
            C0 = *(const f32x4*)cp_; C1 = *(const f32x4*)(cp_ + 4); S0 = *(const f32x4*)sp_; S1 = *(const f32x4*)(sp_ + 4); } while (0)
#pragma unroll
        for (int r = 0; r < 8; ++r) { const int ai = r >> 2, m = r & 3; const int row = EPI_ROW; const float rs = rsv[ai][m];
            f32x4 a0 = acc[ai][0][m][0] * rs + ba0, a1 = acc[ai][0][m][1] * rs + ba1, b0 = acc[ai][1][m][0] * rs + bb0, b1 = acc[ai][1][m][1] * rs + bb1;
            bf16_t* rp = dst + (size_t)row * pitch;
            if (mode == 1) { *(u32x4*)(rp + c0) = pack8(a0 * b0, a1 * b1); }
            else if (mode == 3) {
#pragma unroll
                for (int i = 0; i < 4; ++i) {
                    const float ea0 = __expf(-a0[i]), ea1 = __expf(-a1[i]), eb0 = __expf(-b0[i]), eb1 = __expf(-b1[i]);
                    a0[i] = (1.f + eb0) * __builtin_amdgcn_rcpf(1.f + ea0); a1[i] = (1.f + eb1) * __builtin_amdgcn_rcpf(1.f + ea1); b0[i] = __builtin_amdgcn_rcpf(1.f + eb0); b1[i] = __builtin_amdgcn_rcpf(1.f + eb1); }
                { const size_t po = (size_t)(row >> 1) * (2 * DM) + ((pn - 18) * 4 + wc) * 64 + (row & 1) * 32 + fq * 8;
                  *(u32x4*)(SZC + po) = pack8(a0, a1); *(u32x4*)(SZA + po) = pack8(b0, b1); } }
            else {
                if (mode == 2) { f32x4 cA, cB, sA, sB; ROPE_LOAD(cA, cB, sA, sB, r); const f32x4 x0 = a0, x1 = a1, y0 = b0, y1 = b1;
                    a0 = x0 * cA - y0 * sA; a1 = x1 * cB - y1 * sB; b0 = y0 * cA + x0 * sA; b1 = y1 * cB + x1 * sB; }
                store_lines(stg + (wr * 4 + wc) * 1024, pack8(a0, a1), pack8(b0, b1), fr, fq, dst + (size_t)(row - fr) * pitch + (c0 - fq * 8), pitch); } }
#undef ROPE_LOAD
    }
};

struct EpiDual {
    static constexpr bool PERM = true, AFTER_DRAIN = false, DUAL = true, PREFETCH = false, AIL = false; static constexpr int EPI_VM = 16;
    const bf16_t* rz; const bf16_t* sa; bf16_t* mg; PG8_LAS unsigned char* stg;
    __device__ __forceinline__ void mid(f32x4 (&acc)[2][2][4][2], const Unit& u, int wr, int wc, int fr, int fq) const {
        asm volatile("" : "+v"(fr), "+v"(fq));
        const int col0 = u.pn * BM + wc * 64 + fq * 8;
        EPI_ROWS { const int row = EPI_ROW;
#pragma unroll
            for (int bj = 0; bj < 2; ++bj) { const size_t off = (size_t)(row >> 1) * (2 * DM) + (u.pn * 8 + wc * 2 + bj) * 64 + (row & 1) * 32 + fq * 8; f32x4 g0, g1; unpack8(*(const u32x4*)(rz + off), g0, g1);
                acc[ai][bj][m][0] *= g0; acc[ai][bj][m][1] *= g1; } }
    }
    __device__ __forceinline__ void operator()(const f32x4 (&acc)[2][2][4][2], const Unit& u, int wr, int wc, int fr, int fq) const {
        asm volatile("" : "+v"(fr), "+v"(fq));
        const int col0 = u.pn * BM + wc * 64 + fq * 8;
        u32x4 cg[2], ng[2];
#define SA_LOAD(D, r_) do { const int rw_ = u.pm * BM + ((r_) >> 2) * HALF + wr * 64 + ((r_) & 3) * 16 + fr; const size_t ro_ = (size_t)(rw_ >> 1) * (2 * DM) + (u.pn * 8 + wc * 2) * 64 + (rw_ & 1) * 32 + fq * 8; D[0] = *(const u32x4*)(sa + ro_); D[1] = *(const u32x4*)(sa + ro_ + 64); } while (0)
        SA_LOAD(cg, 0);
#pragma unroll
        for (int r = 0; r < 8; ++r) { const int ai = r >> 2, m = r & 3; const int row = EPI_ROW;
            if (r < 7) SA_LOAD(ng, r + 1);
            u32x4 pm_[2];
#pragma unroll
            for (int bj = 0; bj < 2; ++bj) { f32x4 g0, g1; unpack8(cg[bj], g0, g1); pm_[bj] = pack8(g0 * acc[ai][bj][m][0], g1 * acc[ai][bj][m][1]); }
            store_lines(stg + (wr * 4 + wc) * 1024, pm_[0], pm_[1], fr, fq, mg + (size_t)(row - fr) * DM + u.pn * BM + wc * 64, DM);
            cg[0] = ng[0]; cg[1] = ng[1]; }
#undef SA_LOAD
    }
};
}
using pg8::bf16_t; using pg8::f32x4; using pg8::u32x4; using pg8::u32x2; using pg8::bf16x8; using pg8::f32x16;

__device__ __forceinline__ float wave_sum(float v) {
#pragma unroll
    for (int o = 1; o < 64; o <<= 1) v += __shfl_xor(v, o);
    return v;
}
__device__ __forceinline__ unsigned f2bf(float f) { unsigned u = __builtin_bit_cast(unsigned, f); return (u + 0x7fffu + ((u >> 16) & 1u)) >> 16; }
__device__ __forceinline__ unsigned pk2(float lo, float hi) { return f2bf(lo) | (f2bf(hi) << 16); }

__device__ __forceinline__ int wcperm(int n0) { const int t = n0 & 255; return (n0 & ~255) + 128 * ((t >> 5) & 1) + 32 * (t >> 6); }
__device__ __forceinline__ int dest_row(int kind, int n0) {
    if (kind == 1) { const int half = n0 >= DFF, j = half ? n0 - DFF : n0; return 256 * (j >> 7) + 128 * half + (j & 127); }
    if (kind == 2) {
        if (n0 < 1024) return wcperm(n0);
        if (n0 < 3072) { const int half = n0 >= 2048, j = (n0 - 1024) & 1023; return 1024 + 256 * (j >> 7) + 128 * half + (j & 127); }
        if (n0 < 4352) { const int base = n0 < 4096 ? 3072 : 4096, j = n0 - base, head = j >> 6, dd = j & 63; return base + 256 * (head >> 2) + 128 * (dd >> 5) + 32 * (head & 3) + (dd & 31); }
        if (n0 >= 4608) { const int half = n0 >= 5632, j = (n0 - 4608) & 1023; return 4608 + 256 * (j >> 7) + 128 * half + (j & 127); }
        return wcperm(n0);
    }
    if (kind == 3) return wcperm(n0);
    return n0;
}
__device__ __forceinline__ void p0_transpose_item(const float* W, int K, int N, bf16_t* WT, int kind, LAS float* scr, int item, int lane) {
    const int nblk = N / 32, kb = item / nblk, nb = item % nblk, k0 = 64 * kb, n0 = 32 * nb, dr0 = dest_row(kind, n0);
#pragma unroll 8
    for (int i = 0; i < 32; ++i) { const int kk = 2 * i + (lane >> 5); scr[kk * 33 + (lane & 31)] = W[(size_t)(k0 + kk) * N + n0 + (lane & 31)]; }
    asm volatile("s_waitcnt lgkmcnt(0)" ::: "memory");
    const int c = lane & 7;
#pragma unroll
    for (int j = 0; j < 4; ++j) { const int n = (lane >> 3) + 8 * j; const LAS float* s = scr + (8 * c) * 33 + n;
        u32x4 o; o.x = pk2(s[0 * 33], s[1 * 33]); o.y = pk2(s[2 * 33], s[3 * 33]); o.z = pk2(s[4 * 33], s[5 * 33]); o.w = pk2(s[6 * 33], s[7 * 33]);
        *(u32x4*)(WT + (size_t)(dr0 + n) * K + k0 + 8 * c) = o; }
    asm volatile("s_waitcnt lgkmcnt(0)" ::: "memory");
}

__device__ __forceinline__ void p0_prologue(const Args& A, LAS unsigned char* lds, int tid, int lane, int wave) {
    unsigned char* ws = A.ws;
    float* mods = (float*)(ws + WS_MODS);
    {
        LAS float* sc = (LAS float*)lds; LAS float* red = (LAS float*)(lds + 16384);
        for (int i = tid; i < BATCH * DM; i += 512) { const float v = A.c[i]; sc[i] = v / (1.f + expf(-v)); }
        __syncthreads();
        for (int item = blockIdx.x; item < NMODC / 64; item += gridDim.x) {
            const float* wp = A.w_ada + (size_t)(wave * 128) * NMODC + item * 64 + lane;
            float a0 = 0.f, a1 = 0.f, a2 = 0.f, a3 = 0.f;
#pragma unroll 8
            for (int k = 0; k < 128; ++k) { const float w = wp[(size_t)k * NMODC]; const int kk = wave * 128 + k;
                a0 += sc[kk] * w; a1 += sc[DM + kk] * w; a2 += sc[2 * DM + kk] * w; a3 += sc[3 * DM + kk] * w; }
            red[(wave * 4 + 0) * 64 + lane] = a0; red[(wave * 4 + 1) * 64 + lane] = a1; red[(wave * 4 + 2) * 64 + lane] = a2; red[(wave * 4 + 3) * 64 + lane] = a3;
            __syncthreads();
            if (tid < 256) { const int b = tid >> 6, col = tid & 63; float s = A.b_ada[item * 64 + col];
#pragma unroll
                for (int w = 0; w < 8; ++w) s += red[(w * 4 + b) * 64 + col];
                mods[(size_t)b * NMODC + item * 64 + col] = s; }
            __syncthreads();
        }
        __syncthreads();
    }
    {
        float* cosT = (float*)(ws + WS_COS); float* sinT = (float*)(ws + WS_SIN);
        for (int e = blockIdx.x * 512 + tid; e < SEQ * 32; e += gridDim.x * 512) {
            const int pos = e >> 5, i = e & 31; const float angf = (float)pos * A.inv_freq[i];
            const double a = (double)angf, kq = rint(a * 0.63661977236758134308), r = fma(-kq, 6.123233995736766e-17, fma(-kq, 1.5707963267948966, a)), r2 = r * r;
            double sn = -1.0 / 1307674368000.0; sn = sn * r2 + 1.0 / 6227020800.0; sn = sn * r2 - 1.0 / 39916800.0; sn = sn * r2 + 1.0 / 362880.0; sn = sn * r2 - 1.0 / 5040.0; sn = sn * r2 + 1.0 / 120.0; sn = sn * r2 - 1.0 / 6.0; sn = sn * r2 * r + r;
            double cs = 1.0 / 20922789888000.0; cs = cs * r2 - 1.0 / 87178291200.0; cs = cs * r2 + 1.0 / 479001600.0; cs = cs * r2 - 1.0 / 3628800.0; cs = cs * r2 + 1.0 / 40320.0; cs = cs * r2 - 1.0 / 720.0; cs = cs * r2 + 1.0 / 24.0; cs = cs * r2 - 0.5; cs = cs * r2 + 1.0;
            const int qd = ((int)kq) & 3;
            const double sv = (qd == 0) ? sn : (qd == 1) ? cs : (qd == 2) ? -sn : -cs;
            const double cv = (qd == 0) ? cs : (qd == 1) ? -sn : (qd == 2) ? -cs : sn;
            cosT[e] = (float)cv; sinT[e] = (float)sv;
        }
    }
    {
        LAS float* scr = (LAS float*)(lds + wave * 16384);
        const int gw = blockIdx.x * 8 + wave, NGW = gridDim.x * 8;
        constexpr int I_GU = (DM / 64) * (NGU / 32), I_DN = (DFF / 64) * (DM / 32), I_IN = (DM / 64) * (DIN / 32), I_SQ = (DM / 64) * (DM / 32);
        constexpr int NITEMS = 2 * I_GU + 2 * I_DN + I_IN + 3 * I_SQ;
        for (int it = gw; it < NITEMS; it += NGW) {
            int r = it;
            if (r < I_GU) { p0_transpose_item(A.w1_gu, DM, NGU, (bf16_t*)(ws + WS_W1GU), 1, scr, r, lane); continue; } r -= I_GU;
            if (r < I_DN) { p0_transpose_item(A.w1_down, DFF, DM, (bf16_t*)(ws + WS_W1DN), 3, scr, r, lane); continue; } r -= I_DN;
            if (r < I_IN) { p0_transpose_item(A.w_in, DM, DIN, (bf16_t*)(ws + WS_WIN), 2, scr, r, lane); continue; } r -= I_IN;
            if (r < I_SQ) { p0_transpose_item(A.w_conv_proj, DM, DM, (bf16_t*)(ws + WS_WC), 3, scr, r, lane); continue; } r -= I_SQ;
            if (r < I_SQ) { p0_transpose_item(A.w_attn_proj, DM, DM, (bf16_t*)(ws + WS_WA), 3, scr, r, lane); continue; } r -= I_SQ;
            if (r < I_SQ) { p0_transpose_item(A.w_out, DM, DM, (bf16_t*)(ws + WS_WO), 3, scr, r, lane); continue; } r -= I_SQ;
            if (r < I_GU) { p0_transpose_item(A.w2_gu, DM, NGU, (bf16_t*)(ws + WS_W2GU), 1, scr, r, lane); continue; } r -= I_GU;
            p0_transpose_item(A.w2_down, DFF, DM, (bf16_t*)(ws + WS_W2DN), 3, scr, r, lane);
        }
    }
}

__device__ __forceinline__ void p1_rows(const Args& A, int lane, int wave) {
    unsigned char* ws = A.ws; const float* mods = (const float*)(ws + WS_MODS);
    const int gw = blockIdx.x * 8 + wave, NGW = gridDim.x * 8;
    bf16_t* HB = (bf16_t*)(ws + WS_HB);
    f32x4 nx[4];
    if (gw < M) {
#pragma unroll
        for (int j = 0; j < 4; ++j) nx[j] = ((const f32x4*)(A.x + (size_t)gw * DM) + lane)[64 * j]; }
    for (int m = gw; m < M; m += NGW) {
        const int b = m >> 13;
        f32x4 v[4]; float s = 0.f;
#pragma unroll
        for (int j = 0; j < 4; ++j) v[j] = nx[j];
        if (m + NGW < M) {
#pragma unroll
            for (int j = 0; j < 4; ++j) nx[j] = ((const f32x4*)(A.x + (size_t)(m + NGW) * DM) + lane)[64 * j]; }
#pragma unroll
        for (int j = 0; j < 4; ++j) s += (v[j][0] * v[j][0] + v[j][1] * v[j][1]) + (v[j][2] * v[j][2] + v[j][3] * v[j][3]);
        const float rstd = 1.0f / sqrtf(wave_sum(s) * (1.0f / DM) + RMS_EPS);
        u32x2* o8 = (u32x2*)(HB + (size_t)m * DM) + lane;
#pragma unroll
        for (int j = 0; j < 4; ++j) { const int c = 4 * lane + 256 * j;
            const f32x4 g = *(const f32x4*)(A.g_ffn1 + c), sc = *(const f32x4*)(mods + (size_t)b * NMODC + MOD_SC1 * DM + c), sh = *(const f32x4*)(mods + (size_t)b * NMODC + MOD_SH1 * DM + c);
            const f32x4 h = (v[j] * rstd) * g * (sc + 1.0f) + sh;
            u32x2 w; w.x = pg8::cvt_pk_bf16(h[0], h[1]); w.y = pg8::cvt_pk_bf16(h[2], h[3]); o8[64 * j] = w; }
    }
    for (int it = gw; it < DIN + NGU; it += NGW) {
        const bool second = it >= DIN; const int dr = second ? it - DIN : it;
        const bf16_t* wrow = (const bf16_t*)(ws + (second ? WS_W2GU : WS_WIN)) + (size_t)dr * DM;
        const float* sh = mods + (second ? MOD_SH3 : MOD_SH2) * DM;
        float a0 = 0.f, a1 = 0.f, a2 = 0.f, a3 = 0.f;
#pragma unroll
        for (int j = 0; j < 2; ++j) { const int k = 8 * lane + 512 * j; f32x4 wa, wb; pg8::unpack8(*(const u32x4*)(wrow + k), wa, wb);
#define BDOT(acc_, bb) { const f32x4 s0 = *(const f32x4*)(sh + (size_t)(bb) * NMODC + k), s1 = *(const f32x4*)(sh + (size_t)(bb) * NMODC + k + 4); \
            acc_ += ((wa[0] * s0[0] + wa[1] * s0[1]) + (wa[2] * s0[2] + wa[3] * s0[3])) + ((wb[0] * s1[0] + wb[1] * s1[1]) + (wb[2] * s1[2] + wb[3] * s1[3])); }
            BDOT(a0, 0) BDOT(a1, 1) BDOT(a2, 2) BDOT(a3, 3)
#undef BDOT
        }
        a0 = wave_sum(a0); a1 = wave_sum(a1); a2 = wave_sum(a2); a3 = wave_sum(a3);
        if (lane == 0) { float* bo = (float*)(ws + (second ? WS_BIAS3 : WS_BIAS2)); const int N = second ? NGU : DIN;
            bo[dr] = a0; bo[N + dr] = a1; bo[2 * N + dr] = a2; bo[3 * N + dr] = a3; }
    }
}

__device__ __forceinline__ void p5_conv(const Args& A, int lane, int wave, bf16_t* Gout) {
    unsigned char* ws = A.ws; const bf16_t* BG = (const bf16_t*)(ws + WS_BG); const bf16_t* CU = (const bf16_t*)(ws + WS_CU);
    const int gw = blockIdx.x * 8 + wave, NGW = gridDim.x * 8;
    for (int wi = gw; wi < (M / 32) * 2; wi += NGW) {
        const int r0 = (wi >> 1) * 32, c0 = (wi & 1) * 512 + lane * 8;
        const f32x4 w0a = *(const f32x4*)(A.conv_w + c0), w0b = *(const f32x4*)(A.conv_w + c0 + 4), w1a = *(const f32x4*)(A.conv_w + DM + c0), w1b = *(const f32x4*)(A.conv_w + DM + c0 + 4),
                    w2a = *(const f32x4*)(A.conv_w + 2 * DM + c0), w2b = *(const f32x4*)(A.conv_w + 2 * DM + c0 + 4);
        f32x4 p2a = {0.f, 0.f, 0.f, 0.f}, p2b = p2a, p1a = p2a, p1b = p2a;
        if ((r0 & (SEQ - 1)) != 0) { pg8::unpack8(*(const u32x4*)(CU + (size_t)(r0 - 2) * DM + c0), p2a, p2b); pg8::unpack8(*(const u32x4*)(CU + (size_t)(r0 - 1) * DM + c0), p1a, p1b); }
        u32x4 cq[4], bq[4];
#pragma unroll
        for (int i = 0; i < 4; ++i) { const size_t off = (size_t)(r0 + i) * DM + c0; cq[i] = *(const u32x4*)(CU + off); bq[i] = *(const u32x4*)(BG + off); }
#pragma unroll
        for (int t = 0; t < 32; ++t) { const size_t off = (size_t)(r0 + t) * DM + c0;
            f32x4 ca, cb, ba, bb; pg8::unpack8(cq[t & 3], ca, cb); pg8::unpack8(bq[t & 3], ba, bb);
            if (t + 4 < 32) { const size_t offn = (size_t)(r0 + t + 4) * DM + c0; cq[t & 3] = *(const u32x4*)(CU + offn); bq[t & 3] = *(const u32x4*)(BG + offn); }
            const f32x4 oa = ba * ((w0a * p2a + w1a * p1a) + w2a * ca), ob = bb * ((w0b * p2b + w1b * p1b) + w2b * cb);
            *(u32x4*)(Gout + off) = pg8::pack8(oa, ob);
            p2a = p1a; p2b = p1b; p1a = ca; p1b = cb; }
    }
}

constexpr int KS_OFF = 0, KS_PITCH = 144, VS_OFF = 256 * KS_PITCH, VS_PITCH = 528, OS_OFF = VS_OFF + 64 * VS_PITCH, OS_PITCH = 144, OS_WAVE = 32 * OS_PITCH;
__device__ __forceinline__ void attn_unit(LAS unsigned char* lds, const bf16_t* Q, bf16_t* O, const bf16_t* Kb, const bf16_t* Vb, const float* sinks, int unit, int tid, int lane, int wid, int chain_ui) {
    const int n = unit & 63, g = (unit >> 6) & 3, b = unit >> 8;
    const int r0 = b * SEQ + n * 128;
    const int q = lane & 31, hi = lane >> 5, hq = wid >> 1, head = 4 * g + hq;
    bf16x8 Qf[2][4];
#pragma unroll
    for (int it = 0; it < 2; ++it) { const bf16_t* qp = Q + (size_t)(r0 + 32 * ((wid & 1) * 2 + it) + q) * DM + head * 64;
#pragma unroll
        for (int d0 = 0; d0 < 4; ++d0) Qf[it][d0] = *(const bf16x8*)(qp + 16 * d0 + 8 * hi); }
    const bool full = chain_ui <= 0; const int par = full ? 0 : (chain_ui & 1);
    const int ph0 = par * 128, ph1 = (par ^ 1) * 128;
    u32x4 kk[4], vv[4];
#pragma unroll
    for (int i = 0; i < 4; ++i) { const int t_ = tid + 512 * (i & 1), krl = t_ >> 3, ch = t_ & 7, h = (i < 2) ? 1 : 0;
        kk[i] = (u32x4){0u, 0u, 0u, 0u};
        if (h == 1 || (full && n > 0)) kk[i] = *(const u32x4*)(Kb + (size_t)(r0 - 128 + h * 128 + krl) * 256 + g * 64 + ch * 8); }
#pragma unroll
    for (int i = 0; i < 4; ++i) { const int t_ = tid + 512 * (i & 1), kvl = t_ & 127, c = t_ >> 7, h = (i < 2) ? 1 : 0;
        vv[i] = (u32x4){0u, 0u, 0u, 0u};
        if (h == 1 || (full && n > 0)) vv[i] = *(const u32x4*)(Vb + (size_t)(r0 - 128 + h * 128 + kvl) * 256 + g * 64 + c * 8); }
#pragma unroll
    for (int i = 0; i < 4; ++i) { const int t_ = tid + 512 * (i & 1), krl = t_ >> 3, ch = t_ & 7, h = (i < 2) ? 1 : 0;
        if (h == 1 || full) *(LAS u32x4*)(lds + KS_OFF + ((h ? ph1 : ph0) + krl) * KS_PITCH + ch * 16) = kk[i]; }
#pragma unroll
    for (int i = 0; i < 4; ++i) { const int t_ = tid + 512 * (i & 1), kvl = t_ & 127, c = t_ >> 7, h = (i < 2) ? 1 : 0;
        if (h == 1 || full) { LAS bf16_t* vp = (LAS bf16_t*)(lds + VS_OFF + (c * 8) * VS_PITCH + ((h ? ph1 : ph0) + kvl) * 2);
#pragma unroll
            for (int e = 0; e < 8; ++e) { const unsigned w = vv[i][e >> 1]; vp[e * (VS_PITCH / 2)] = (bf16_t)((e & 1) ? (w >> 16) : (w & 0xffffu)); } } }
    asm volatile("s_waitcnt lgkmcnt(0)" ::: "memory"); __builtin_amdgcn_s_barrier(); asm volatile("" ::: "memory");
    const int ks = (q & 0x13) | ((q & 4) << 1) | ((q & 8) >> 1);
    const float sink = sinks[head];
#pragma unroll
    for (int it = 0; it < 2; ++it) {
        const int rb = (wid & 1) * 2 + it;
        f32x16 S[5];
#pragma unroll
        for (int j = 0; j < 5; ++j) {
#pragma unroll
            for (int r = 0; r < 16; ++r) S[j][r] = 0.f;
#pragma unroll
            for (int d0 = 0; d0 < 4; ++d0) { const bf16x8 Kf = *(const LAS bf16x8*)(lds + KS_OFF + ((((rb + j) >> 2) ? ph1 : ph0) + ((32 * (rb + j)) & 127) + ks) * KS_PITCH + (16 * d0 + 8 * hi) * 2);
                S[j] = __builtin_amdgcn_mfma_f32_32x32x16_bf16(Kf, Qf[it][d0], S[j], 0, 0, 0); } }
        float mx = -3.0e38f;
#pragma unroll
        for (int j = 0; j < 5; ++j) { const bool tile_ok = (n > 0) || (rb + j >= 4);
#pragma unroll
            for (int r = 0; r < 16; ++r) { const int off = 16 * (r >> 3) + 8 * hi + (r & 7), diff = 128 + q - 32 * j - off;
                bool ok = tile_ok; if (j == 0) ok = ok && (diff < 128); if (j == 4) ok = ok && (diff >= 0);
                const float sv = ok ? S[j][r] * 0.125f : -1e30f; S[j][r] = sv; mx = fmaxf(mx, sv); } }
        mx = fmaxf(mx, __shfl_xor(mx, 32)); mx = fmaxf(mx, sink);
        const float L2E = 1.4426950408889634f, mneg = -mx * L2E;
        float sum = 0.f;
#pragma unroll
        for (int j = 0; j < 5; ++j)
#pragma unroll
            for (int r = 0; r < 16; ++r) { const float pv = __builtin_amdgcn_exp2f(S[j][r] * L2E + mneg); S[j][r] = pv; sum += pv; }
        sum += __shfl_xor(sum, 32);
        const float inv = 1.0f / (sum + __builtin_amdgcn_exp2f((sink - mx) * L2E));
        f32x16 O0, O1;
#pragma unroll
        for (int r = 0; r < 16; ++r) { O0[r] = 0.f; O1[r] = 0.f; }
#pragma unroll
        for (int j = 0; j < 5; ++j)
#pragma unroll
            for (int st = 0; st < 2; ++st) {
                u32x4 pw; pw.x = pg8::cvt_pk_bf16(S[j][8 * st + 0], S[j][8 * st + 1]); pw.y = pg8::cvt_pk_bf16(S[j][8 * st + 2], S[j][8 * st + 3]);
                pw.z = pg8::cvt_pk_bf16(S[j][8 * st + 4], S[j][8 * st + 5]); pw.w = pg8::cvt_pk_bf16(S[j][8 * st + 6], S[j][8 * st + 7]);
                const bf16x8 Pf = __builtin_bit_cast(bf16x8, pw);
                const int kvoff = ((((rb + j) >> 2) ? ph1 : ph0) + ((32 * (rb + j)) & 127) + 16 * st + 8 * hi) * 2;
                const bf16x8 V0 = *(const LAS bf16x8*)(lds + VS_OFF + q * VS_PITCH + kvoff), V1 = *(const LAS bf16x8*)(lds + VS_OFF + (32 + q) * VS_PITCH + kvoff);
                O0 = __builtin_amdgcn_mfma_f32_32x32x16_bf16(V0, Pf, O0, 0, 0, 0); O1 = __builtin_amdgcn_mfma_f32_32x32x16_bf16(V1, Pf, O1, 0, 0, 0); }
        { LAS unsigned char* ost = lds + OS_OFF + wid * OS_WAVE;
#pragma unroll
          for (int r4 = 0; r4 < 4; ++r4) { const int d = 8 * r4 + 4 * hi;
            u32x2 w0, w1; w0.x = pg8::cvt_pk_bf16(O0[4 * r4] * inv, O0[4 * r4 + 1] * inv); w0.y = pg8::cvt_pk_bf16(O0[4 * r4 + 2] * inv, O0[4 * r4 + 3] * inv);
            w1.x = pg8::cvt_pk_bf16(O1[4 * r4] * inv, O1[4 * r4 + 1] * inv); w1.y = pg8::cvt_pk_bf16(O1[4 * r4 + 2] * inv, O1[4 * r4 + 3] * inv);
            *(LAS u32x2*)(ost + q * OS_PITCH + d * 2) = w0; *(LAS u32x2*)(ost + q * OS_PITCH + (32 + d) * 2) = w1; }
          __builtin_amdgcn_wave_barrier(); asm volatile("" ::: "memory");
          bf16_t* ob = O + (size_t)(r0 + 32 * rb) * DM + head * 64;
#pragma unroll
          for (int ps = 0; ps < 4; ++ps) { const int rr = 8 * ps + (lane >> 3), pc = lane & 7;
            const u32x4 v = *(const LAS u32x4*)(ost + rr * OS_PITCH + pc * 16);
            *(u32x4*)(ob + (size_t)rr * DM + pc * 8) = v; }
          __builtin_amdgcn_wave_barrier(); asm volatile("" ::: "memory"); }
    }
    asm volatile("s_waitcnt lgkmcnt(0)" ::: "memory"); __builtin_amdgcn_s_barrier(); asm volatile("" ::: "memory");
}

__device__ __forceinline__ void p10_final(const Args& A, int lane, int wave, float* outp) {
    const float* ssq = (const float*)(A.ws + WS_SSQF); const bf16_t* X3 = (const bf16_t*)(A.ws + WS_X3);
    const int gw = blockIdx.x * 8 + wave, NGW = gridDim.x * 8;
    for (int m = gw; m < M; m += NGW) { const float rs = pg8::rstd_from(ssq, m);
#pragma unroll
        for (int j = 0; j < 2; ++j) { const int c = 8 * lane + 512 * j; f32x4 a, b; pg8::unpack8(*(const u32x4*)(X3 + (size_t)m * DM + c), a, b);
            *(f32x4*)(outp + (size_t)m * DM + c) = (a * rs) * *(const f32x4*)(A.g_final + c); *(f32x4*)(outp + (size_t)m * DM + c + 4) = (b * rs) * *(const f32x4*)(A.g_final + c + 4); } }
}

constexpr int N_PHASES = 11;
__global__ void __launch_bounds__(512, 2) mk_fwd(Args A) {
    extern __shared__ __attribute__((aligned(16))) unsigned char lds_raw[];
    LAS unsigned char* lds = (LAS unsigned char*)lds_raw;
    cg::grid_group grid = cg::this_grid();
    const int tid = threadIdx.x, lane = tid & 63, wave = __builtin_amdgcn_readfirstlane(tid >> 6);
    const int lo = A.ph_lo, hi = A.ph_hi, G = gridDim.x, cid = blockIdx.x;
    unsigned char* ws = A.ws;
    const float* mods = (const float*)(ws + WS_MODS);
    bf16_t* const RES = (bf16_t*)((unsigned char*)A.out + OUT_RES);
#define IN(k) (lo <= (k) && (k) < hi)
    if (tid < 2) ((LAS unsigned*)(lds + LDS_BARW))[tid] = 0u;
    __syncthreads();
    XcdBarrier bar; bar.bar = (unsigned*)(ws + WS_CTL); bar.x = 0; bar.st = nullptr;
    if (hi - lo > 1) bar = xcd_barrier_post((unsigned*)(ws + WS_CTL), (volatile LAS unsigned*)(lds + LDS_BARW));
    if (lo < 0) grid.sync();
#define SEAM(k) do { if (IN(k) && IN((k) + 1)) xcd_barrier(bar); } while (0)
    if (IN(0)) { p0_prologue(A, lds, tid, lane, wave); } SEAM(0);
    if (IN(1)) { p1_rows(A, lane, wave); } SEAM(1);
    if (IN(2)) { pg8::Gemm g{(const bf16_t*)(ws + WS_HB), (const bf16_t*)(ws + WS_W1GU), M, NGU, DM}; pg8::StaticOrder S; S.init(M, NGU, G, cid);
        pg8::EpiGU<false> E{(bf16_t*)(ws + WS_ACT1), nullptr, nullptr, nullptr};
        pg8::gemm_phase<pg8::EpiGU<false>, pg8::StaticOrder, true, true>(lds, g, S, E); } SEAM(2);
    if (IN(3)) { pg8::Gemm g{(const bf16_t*)(ws + WS_ACT1), (const bf16_t*)(ws + WS_W1DN), M, DM, DFF}; pg8::StaticOrder S; S.init(M, DM, G, cid);
        pg8::EpiRes<true, true, false, true> E{A.x, RES, mods + MOD_GT1 * DM, (bf16_t*)(ws + WS_HB), A.g_mix, mods + MOD_SC2 * DM, (float*)(ws + WS_SSQ2), lds + LDS_STG};
        pg8::gemm_phase<pg8::EpiRes<true, true, false, true>, pg8::StaticOrder, true, true>(lds, g, S, E); } SEAM(3);
    if (IN(4)) { pg8::Gemm g{(const bf16_t*)(ws + WS_HB), (const bf16_t*)(ws + WS_WIN), M, DIN, DM}; pg8::StaticOrder S; S.init(M, DIN, G, cid);
        pg8::EpiIn E{lds + LDS_SCR, lds + LDS_STG, (const float*)(ws + WS_SSQ2), (const float*)(ws + WS_BIAS2), (const float*)(ws + WS_COS), (const float*)(ws + WS_SIN),
                     (bf16_t*)(ws + WS_BG), (bf16_t*)(ws + WS_CU), (bf16_t*)(ws + WS_Q), (bf16_t*)(ws + WS_K), (bf16_t*)(ws + WS_V), (bf16_t*)(ws + WS_SZC), (bf16_t*)(ws + WS_SZA)};
        pg8::gemm_phase<pg8::EpiIn, pg8::StaticOrder, true, true>(lds, g, S, E); } SEAM(4);
    if (IN(5)) { int t5 = threadIdx.x; asm volatile("" : "+v"(t5)); const int l5 = t5 & 63;
        p5_conv(A, l5, wave, (bf16_t*)(ws + WS_BG));
        const bool xmap = (G * 4 == BATCH * 4 * (SEQ / 128)) && (G % 8 == 0); const int vcu = xmap ? (cid % 8) * (G / 8) + cid / 8 : cid;
        for (int ui = 0, u = xmap ? 4 * vcu : cid; u < BATCH * 4 * (SEQ / 128) && (!xmap || ui < 4); ++ui, u += xmap ? 1 : G) attn_unit(lds, (const bf16_t*)(ws + WS_Q), (bf16_t*)(ws + WS_Q), (const bf16_t*)(ws + WS_K), (const bf16_t*)(ws + WS_V), A.sinks, u, t5, l5, wave, xmap ? ui : 0); } SEAM(5);
    if (IN(6)) { pg8::Gemm g{(const bf16_t*)(ws + WS_BG), (const bf16_t*)(ws + WS_WC), M, DM, DM, (const bf16_t*)(ws + WS_Q), (const bf16_t*)(ws + WS_WA)}; pg8::DualOrder S; S.init(M, DM, G, cid);
        pg8::EpiDual E{(const bf16_t*)(ws + WS_SZC), (const bf16_t*)(ws + WS_SZA), (bf16_t*)(ws + WS_HB), lds + LDS_STG};
        pg8::gemm_phase<pg8::EpiDual, pg8::DualOrder, true, true>(lds, g, S, E); } SEAM(6);
    if (IN(7)) { pg8::Gemm g{(const bf16_t*)(ws + WS_HB), (const bf16_t*)(ws + WS_WO), M, DM, DM}; pg8::StaticOrder S; S.init(M, DM, G, cid);
        pg8::EpiRes<false, true, true, false> E{RES, RES, mods + MOD_GT2 * DM, (bf16_t*)(ws + WS_BG), A.g_ffn2, mods + MOD_SC3 * DM, (float*)(ws + WS_SSQ3), lds + LDS_STG};
        pg8::gemm_phase<pg8::EpiRes<false, true, true, false>, pg8::StaticOrder, true, true>(lds, g, S, E); } SEAM(7);
    if (IN(8)) { pg8::Gemm g{(const bf16_t*)(ws + WS_BG), (const bf16_t*)(ws + WS_W2GU), M, NGU, DM}; pg8::StaticOrder S; S.init(M, NGU, G, cid);
        pg8::EpiGU<true> E{(bf16_t*)(ws + WS_ACT2), (const float*)(ws + WS_SSQ3), (const float*)(ws + WS_BIAS3), lds + LDS_SCR};
        pg8::gemm_phase<pg8::EpiGU<true>, pg8::StaticOrder, true, true>(lds, g, S, E); } SEAM(8);
    if (IN(9)) { pg8::Gemm g{(const bf16_t*)(ws + WS_ACT2), (const bf16_t*)(ws + WS_W2DN), M, DM, DFF}; pg8::StaticOrder S; S.init(M, DM, G, cid);
        pg8::EpiRes<true, false, true, true> E{RES, (bf16_t*)(ws + WS_X3), mods + MOD_GT3 * DM, nullptr, nullptr, nullptr, (float*)(ws + WS_SSQF), lds + LDS_STG};
        pg8::gemm_phase<pg8::EpiRes<true, false, true, true>, pg8::StaticOrder, true, true>(lds, g, S, E); } SEAM(9);
    if (IN(10)) { int t10 = threadIdx.x; asm volatile("" : "+v"(t10)); p10_final(A, t10 & 63, wave, A.out); }
#undef IN
#undef SEAM
}

#ifndef MK_PER_PHASE
#define MK_PER_PHASE 0
#endif
extern "C" void kernel_launch(void* const* d_in, const int* in_sizes, int n_in, void* d_out, int out_size, void* d_ws, size_t ws_size, hipStream_t stream) {
    static int grid = 0;
    if (grid == 0) {
        if (n_in != 18 || in_sizes[0] != M * DM || out_size != M * DM || ws_size < WS_END) { fprintf(stderr, "kernel_launch: unexpected shapes (n_in %d, in0 %d, out %d, ws %zu); nothing launched\n", n_in, n_in > 0 ? in_sizes[0] : -1, out_size, ws_size); grid = -1; return; }
        int dev = 0, cus = 0, per_cu = 0;
        if (hipGetDevice(&dev) != hipSuccess || hipDeviceGetAttribute(&cus, hipDeviceAttributeMultiprocessorCount, dev) != hipSuccess) { grid = -1; return; }
        if (hipFuncSetAttribute((const void*)mk_fwd, hipFuncAttributeMaxDynamicSharedMemorySize, LDS_BYTES) != hipSuccess) { fprintf(stderr, "kernel_launch: hipFuncSetAttribute failed\n"); grid = -1; return; }
        if (hipOccupancyMaxActiveBlocksPerMultiprocessor(&per_cu, (const void*)mk_fwd, 512, LDS_BYTES) != hipSuccess || per_cu < 1) { fprintf(stderr, "kernel_launch: occupancy query failed (%d)\n", per_cu); (void)hipGetLastError(); per_cu = 1; }
        grid = cus * (per_cu > 1 ? 1 : per_cu);
    }
    if (grid < 0) return;
    if (hipMemsetAsync((char*)d_ws + WS_CTL, 0, CTL_BYTES, stream) != hipSuccess) { fprintf(stderr, "kernel_launch: memset failed\n"); return; }
    Args a{};
    const float** pp = &a.x;
    for (int i = 0; i < 18; ++i) pp[i] = (const float*)d_in[i];
    a.out = (float*)d_out; a.ws = (unsigned char*)d_ws;
    for (int i = 0; i < 32; ++i) { const float e = (float)(2 * i) / 64.0f; a.inv_freq[i] = 1.0f / powf(10000.0f, e); }
    const int nl = MK_PER_PHASE ? N_PHASES : 1;
    for (int li = 0; li < nl; ++li) {
        a.ph_lo = MK_PER_PHASE ? li : 0; a.ph_hi = MK_PER_PHASE ? li + 1 : N_PHASES;
        void* args[] = {&a};
        const hipError_t e = hipLaunchCooperativeKernel((const void*)mk_fwd, dim3(grid), dim3(512), args, LDS_BYTES, stream);
        if (e != hipSuccess) { fprintf(stderr, "kernel_launch: cooperative launch %d failed: %s (grid %d)\n", li, hipGetErrorString(e), grid); break; }
    }
}
```

```cpp
#include <hip/hip_runtime.h>
#include <hip/hip_cooperative_groups.h>
#include <cstdio>
#include <cstdint>
#include <cmath>
namespace cg = cooperative_groups;
namespace pg8 {
#define PG8_LAS __attribute__((address_space(3)))
typedef unsigned short bf16_t;
typedef short bf16x8 __attribute__((ext_vector_type(8)));
typedef float f32x4 __attribute__((ext_vector_type(4)));
typedef unsigned u32x4 __attribute__((ext_vector_type(4)));
constexpr int BM = 256, BK = 64, HALF = 128, HTB = HALF * BK * 2  , STAGE_BYTES = 8 * HTB, NXCD = 8, WGM = 2;

__host__ __device__ __forceinline__ int lds_byte(int r, int c) { const int st = (r >> 4) * 2 + (c >> 5), rr = r & 15, cc = c & 31, ob = rr * 64 + cc * 2; return st * 1024 + (ob ^ (((ob >> 9) & 1) << 5)); }
__host__ __device__ __forceinline__ void stage_rc(int b, int& R, int& C) { const int st = b / 1024, sb = b % 1024, swz = sb ^ (((sb >> 9) & 1) << 5); R = (st >> 1) * 16 + swz / 64; C = (st & 1) * 32 + (swz % 64) / 2; }
__host__ __device__ __forceinline__ int perm32(int rho) { const int n = rho >> 4, i = rho & 15; return 8 * (i >> 2) + 4 * n + (i & 3); }

struct Unit { int pm, pn, sel; };
struct Gemm { const bf16_t* A; const bf16_t* Bt; int M, N, K; const bf16_t* A2; const bf16_t* Bt2; };

struct StaticOrder {
    int nM, nN, nwg, G, c;
    __host__ __device__ void init(int M, int N, int G_, int c_) { nM = M / BM; nN = N / BM; nwg = nM * nN; G = G_; c = c_; }
    __host__ __device__ bool next(int i, Unit& u) const {
        const long L = (long)i * G + c; if (L >= nwg) return false;
        int wgid = (int)L; { const int q = nwg / NXCD, r = nwg % NXCD, xcd = wgid % NXCD, off = wgid / NXCD; wgid = (xcd < r ? xcd * (q + 1) : r * (q + 1) + (xcd - r) * q) + off; }
        const int nig = WGM * nN, gid = wgid / nig, fm = gid * WGM, gsz = (nM - fm) < WGM ? (nM - fm) : WGM;
        u.pm = fm + ((wgid % nig) % gsz); u.pn = (wgid % nig) / gsz; u.sel = 0; return true;
    }
    __device__ __forceinline__ void a_ready(const Unit&) const {}
    __device__ __forceinline__ void done(const Unit&) const {}
};

struct DualOrder {
    StaticOrder b;
    __host__ __device__ void init(int M, int N, int G_, int c_) { b.init(M, N, G_, c_); }
    __host__ __device__ bool next(int i, Unit& u) const { if (!b.next(i >> 1, u)) return false; u.sel = i & 1; return true; }
    __device__ __forceinline__ void a_ready(const Unit&) const {}
    __device__ __forceinline__ void done(const Unit&) const {}
};
__device__ __forceinline__ unsigned cvt_pk_bf16(float lo, float hi) { unsigned r; asm volatile("v_cvt_pk_bf16_f32 %0, %1, %2" : "=v"(r) : "v"(lo), "v"(hi)); return r; }
typedef float f32x2 __attribute__((ext_vector_type(2)));
template <class Epi, class Sched, bool ALIGN_EPI = false, bool SP2 = false>
__device__ __forceinline__ void gemm_phase(PG8_LAS unsigned char* lds, const Gemm g, const Sched& S, const Epi& E) {
    const int tid = threadIdx.x, wid = __builtin_amdgcn_readfirstlane(tid >> 6), lane = tid & 63, wr = wid >> 2, wc = wid & 3, fr = lane & 15, fq = lane >> 4;
    const int K = g.K, nt = K / BK;
    unsigned voffA[2], voffB[2];
#pragma unroll
    for (int i = 0; i < 2; ++i) { int R, C; stage_rc(tid * 16 + i * 8192, R, C); const int Rb = Epi::PERM ? ((R & ~31) + perm32(R & 31)) : R;
        voffA[i] = Epi::AIL ? (unsigned)((R >> 1) * (2 * K) + (C >> 5) * 64 + (R & 1) * 32 + (C & 31)) * 2u : (unsigned)(R * K + C) * 2u; voffB[i] = (unsigned)(Rb * K + C) * 2u; }
    const size_t kstep = (size_t)(BK * 2);
    const size_t kstepA = Epi::AIL ? (size_t)(BK * 4) : kstep;
    const size_t hstep = (size_t)HALF * K * 2;
    const size_t tstep = 2 * hstep;
    const unsigned ldsw = (unsigned)wid * 1024u;
    const int aoff = lds_byte(wr * 64 + fr, fq * 8), boff = lds_byte(wc * 32 + fr, fq * 8);
#define PG8_ABASE(u) ((const char*)((Epi::DUAL && (u).sel) ? g.A2 : g.A) + (size_t)(u).pm * tstep)
#define PG8_BBASE(u) ((const char*)((Epi::DUAL && (u).sel) ? g.Bt2 : g.Bt) + (size_t)(u).pn * tstep)
#define PG8_SA(b, h) (((b) * 2 + (h)) * HTB)
#define PG8_SB(b, h) ((4 + (b) * 2 + (h)) * HTB)
#define PG8_STAGE(bufoff, gbase, voff) do { _Pragma("unroll") for (int _i = 0; _i < 2; ++_i) \
        __builtin_amdgcn_global_load_lds((const unsigned*)((const char*)(gbase) + (voff)[_i]), (PG8_LAS unsigned*)(lds + (bufoff) + ldsw + _i * 8192), 16, 0, 0); } while (0)
#define PG8_LDA(dst, b, h) do { _Pragma("unroll") for (int m = 0; m < 4; ++m) _Pragma("unroll") for (int k = 0; k < 2; ++k) dst[m][k] = *(const PG8_LAS bf16x8*)(lds + PG8_SA(b, h) + aoff + m * 2048 + k * 1024); } while (0)
#define PG8_LDB(dst, b, h) do { _Pragma("unroll") for (int n = 0; n < 2; ++n) _Pragma("unroll") for (int k = 0; k < 2; ++k) dst[n][k] = *(const PG8_LAS bf16x8*)(lds + PG8_SB(b, h) + boff + n * 2048 + k * 1024); } while (0)
#define PG8_MMA(ai, bj, At, Bt) do { __builtin_amdgcn_s_setprio(1); _Pragma("unroll") for (int m = 0; m < 4; ++m) _Pragma("unroll") for (int n = 0; n < 2; ++n) _Pragma("unroll") for (int k = 0; k < 2; ++k) \
        acc[ai][bj][m][n] = __builtin_amdgcn_mfma_f32_16x16x32_bf16(Bt[n][k], At[m][k], acc[ai][bj][m][n], 0, 0, 0); __builtin_amdgcn_s_setprio(0); } while (0)
#define PG8_WAIT_V(n) asm volatile("s_waitcnt vmcnt(" #n ")" ::: "memory")
#define PG8_WAIT_L(n) asm volatile("s_waitcnt lgkmcnt(" #n ")" ::: "memory")
#define PG8_BAR __builtin_amdgcn_s_barrier()
#define PG8_SCHED __builtin_amdgcn_sched_barrier(0)
    Unit cur, nxt; int ui = 0;
    int tpf = 0; asm volatile("" : "+s"(tpf));
    if (!S.next(0, cur)) return;
    f32x4 acc[2][2][4][2];
#pragma unroll
    for (int a = 0; a < 2; ++a)
#pragma unroll
        for (int b = 0; b < 2; ++b)
#pragma unroll
            for (int m = 0; m < 4; ++m)
#pragma unroll
                for (int n = 0; n < 2; ++n) acc[a][b][m][n] = (f32x4){0.f, 0.f, 0.f, 0.f};
    bf16x8 At[4][2], B0[2][2], B1[2][2];
    const char* cA = PG8_ABASE(cur); const char* cB = PG8_BBASE(cur);
    S.a_ready(cur);
    if constexpr (SP2) {
        PG8_STAGE(PG8_SB(0, 0), cB, voffB); PG8_STAGE(PG8_SB(0, 1), cB + hstep, voffB); PG8_STAGE(PG8_SA(0, 0), cA, voffA); PG8_STAGE(PG8_SA(0, 1), cA + hstep, voffA);
        if (wr == 1) PG8_BAR;
        PG8_WAIT_V(2); PG8_BAR;
        PG8_STAGE(PG8_SB(1, 0), cB + kstep, voffB); PG8_STAGE(PG8_SA(1, 0), cA + kstepA, voffA); PG8_STAGE(PG8_SB(1, 1), cB + hstep + kstep, voffB);
        PG8_WAIT_V(6); PG8_BAR;
    } else {
        PG8_STAGE(PG8_SB(0, 0), cB, voffB); PG8_STAGE(PG8_SA(0, 0), cA, voffA); PG8_STAGE(PG8_SB(0, 1), cB + hstep, voffB); PG8_STAGE(PG8_SA(0, 1), cA + hstep, voffA);
        if (wr == 1) PG8_BAR;
        PG8_WAIT_V(4); PG8_BAR;
        PG8_STAGE(PG8_SB(1, 0), cB + kstep, voffB); PG8_STAGE(PG8_SA(1, 0), cA + kstepA, voffA); PG8_STAGE(PG8_SB(1, 1), cB + hstep + kstep, voffB);
        PG8_WAIT_V(6); PG8_BAR;
    }
    for (;;) {
        const bool has_next = S.next(ui + 1, nxt);
        const char* nA = has_next ? PG8_ABASE(nxt) : cA; const char* nB = has_next ? PG8_BBASE(nxt) : cB;
        for (int t = 0; t < nt; t += 2) {
            const bool last = (t == nt - 2);
            const char* a1 = cA + (size_t)(t + 1) * kstepA;
            const char* a2 = last ? nA : cA + (size_t)(t + 2) * kstepA; const char* b2 = last ? nB : cB + (size_t)(t + 2) * kstep;
            const char* a3 = a2 + kstepA; const char* b3 = b2 + kstep;
            if (last && has_next) S.a_ready(nxt);
            if constexpr (SP2) {
            PG8_LDB(B0, 0, 0); PG8_LDB(B1, 0, 1); PG8_SCHED; PG8_LDA(At, 0, 0); PG8_STAGE(PG8_SA(1, 1), a1 + hstep, voffA);
            PG8_WAIT_V(8); PG8_WAIT_L(0); PG8_BAR; PG8_MMA(0, 0, At, B0); PG8_MMA(0, 1, At, B1); PG8_BAR; PG8_SCHED;
            if constexpr (Epi::PREFETCH) { if (t == tpf) E.prefetch(cur, wid, lane); }
            PG8_LDA(At, 0, 1); PG8_STAGE(PG8_SB(0, 0), b2, voffB); PG8_STAGE(PG8_SB(0, 1), b2 + hstep, voffB); PG8_STAGE(PG8_SA(0, 0), a2, voffA);
            PG8_WAIT_V(8); PG8_WAIT_L(0); PG8_BAR; PG8_MMA(1, 0, At, B0); PG8_MMA(1, 1, At, B1); PG8_BAR; PG8_SCHED;
            PG8_LDB(B0, 1, 0); PG8_LDB(B1, 1, 1); PG8_SCHED; PG8_LDA(At, 1, 0); PG8_STAGE(PG8_SA(0, 1), a2 + hstep, voffA);
            PG8_WAIT_V(8); PG8_WAIT_L(0); PG8_BAR; PG8_MMA(0, 0, At, B0); PG8_MMA(0, 1, At, B1); PG8_BAR; PG8_SCHED;
            PG8_LDA(At, 1, 1); PG8_STAGE(PG8_SB(1, 0), b3, voffB); PG8_STAGE(PG8_SB(1, 1), b3 + hstep, voffB); PG8_STAGE(PG8_SA(1, 0), a3, voffA);
            PG8_WAIT_V(8); PG8_WAIT_L(0); PG8_BAR; PG8_MMA(1, 0, At, B0); PG8_MMA(1, 1, At, B1); PG8_BAR; PG8_SCHED;
            } else {
            PG8_LDB(B0, 0, 0); PG8_SCHED; PG8_LDA(At, 0, 0); PG8_STAGE(PG8_SA(1, 1), a1 + hstep, voffA);
            PG8_WAIT_L(8); PG8_BAR; PG8_WAIT_L(0); PG8_MMA(0, 0, At, B0); PG8_BAR; PG8_SCHED;
            PG8_LDB(B1, 0, 1); PG8_STAGE(PG8_SB(0, 0), b2, voffB);
            PG8_BAR; PG8_WAIT_L(0); PG8_MMA(0, 1, At, B1); PG8_BAR;
            PG8_LDA(At, 0, 1); PG8_STAGE(PG8_SA(0, 0), a2, voffA);
            PG8_BAR; PG8_WAIT_L(0); PG8_MMA(1, 0, At, B0); PG8_BAR; PG8_SCHED;
            PG8_STAGE(PG8_SB(0, 1), b2 + hstep, voffB);
            PG8_WAIT_V(6); PG8_BAR; PG8_MMA(1, 1, At, B1); PG8_BAR;
            PG8_LDB(B0, 1, 0); PG8_SCHED; PG8_LDA(At, 1, 0); PG8_STAGE(PG8_SA(0, 1), a2 + hstep, voffA);
            PG8_WAIT_L(8); PG8_BAR; PG8_WAIT_L(0); PG8_MMA(0, 0, At, B0); PG8_BAR; PG8_SCHED;
            PG8_LDB(B1, 1, 1); PG8_STAGE(PG8_SB(1, 0), b3, voffB);
            PG8_BAR; PG8_WAIT_L(0); PG8_MMA(0, 1, At, B1); PG8_BAR;
            PG8_LDA(At, 1, 1); PG8_STAGE(PG8_SA(1, 0), a3, voffA);
            PG8_BAR; PG8_WAIT_L(0); PG8_MMA(1, 0, At, B0); PG8_BAR; PG8_SCHED;
            PG8_STAGE(PG8_SB(1, 1), b3 + hstep, voffB);
            PG8_WAIT_V(6); PG8_BAR; PG8_MMA(1, 1, At, B1); PG8_BAR;
            }
        }
        if constexpr (ALIGN_EPI) { if (wr == 0) PG8_BAR; }
        if constexpr (!Epi::AFTER_DRAIN) { if constexpr (Epi::DUAL) { if (cur.sel == 0) E.mid(acc, cur, wr, wc, fr, fq); else E(acc, cur, wr, wc, fr, fq); } else { E(acc, cur, wr, wc, fr, fq); } S.done(cur); }
        if (!has_next) break;
        if (!(Epi::DUAL && cur.sel == 0))
#pragma unroll
        for (int a = 0; a < 2; ++a)
#pragma unroll
            for (int b = 0; b < 2; ++b)
#pragma unroll
                for (int m = 0; m < 4; ++m)
#pragma unroll
                    for (int n = 0; n < 2; ++n) acc[a][b][m][n] = (f32x4){0.f, 0.f, 0.f, 0.f};
        cur = nxt; cA = nA; cB = nB; ++ui;
        if constexpr (ALIGN_EPI) { if (wr == 1) PG8_BAR; }
    }
    PG8_WAIT_V(0);
    if constexpr (!ALIGN_EPI) { if (wr == 0) PG8_BAR; }
    PG8_BAR;
    if constexpr (Epi::AFTER_DRAIN) { E.fused(acc, cur, wr, wc, fr, fq, lds, wid, lane); S.done(cur); }
#undef PG8_SA
#undef PG8_ABASE
#undef PG8_BBASE
#undef PG8_SB
#undef PG8_STAGE
#undef PG8_LDA
#undef PG8_LDB
#undef PG8_MMA
#undef PG8_WAIT_V
#undef PG8_WAIT_L
#undef PG8_BAR
#undef PG8_SCHED
}
}

constexpr int BATCH = 4, SEQ = 8192, DM = 1024, M = BATCH * SEQ, DFF = 2816, NGU = 2 * DFF, DIN = 6656, NMODC = 9 * DM;
constexpr float RMS_EPS = 1e-6f;
enum { MOD_SH1 = 0, MOD_SC1, MOD_GT1, MOD_SH2, MOD_SC2, MOD_GT2, MOD_SH3, MOD_SC3, MOD_GT3 };

constexpr size_t MiB = 1u << 20;
constexpr size_t WS_MODS = 0, WS_BIAS2 = 256 * 1024, WS_BIAS3 = 384 * 1024, WS_CTL = 512 * 1024  , CTL_BYTES = 16384, WS_COS = 1 * MiB, WS_SIN = 2 * MiB;
constexpr size_t WS_SSQ2 = 3 * MiB, WS_SSQ3 = 5 * MiB, WS_SSQF = 7 * MiB;
constexpr size_t WS_W1GU = 9 * MiB, WS_W1DN = 20 * MiB, WS_WIN = 26 * MiB, WS_WC = 39 * MiB, WS_WA = 41 * MiB, WS_WO = 43 * MiB, WS_W2GU = 45 * MiB, WS_W2DN = 56 * MiB;
constexpr size_t WS_HB = 64 * MiB;
constexpr size_t WS_BG = 128 * MiB;
constexpr size_t WS_Q = 192 * MiB;
constexpr size_t WS_SZC = 256 * MiB, WS_SZA = 320 * MiB;
constexpr size_t WS_CU = 384 * MiB;
constexpr size_t WS_K = 448 * MiB, WS_V = 464 * MiB;
constexpr size_t WS_PART = 384 * MiB;
constexpr size_t WS_ACT1 = 128 * MiB, WS_ACT2 = 192 * MiB;
constexpr size_t WS_X3 = 128 * MiB;
constexpr size_t OUT_RES = 64 * MiB;
constexpr size_t WS_END = 512 * MiB;
static_assert(WS_W2DN + (size_t)DM * DFF * 2 <= WS_HB && WS_ACT2 + (size_t)M * DFF * 2 <= WS_PART, "ws map");

#define LAS __attribute__((address_space(3)))
constexpr int LDS_SCR = 131072, LDS_BARW = LDS_SCR + 17408, LDS_STG = LDS_BARW + 256, LDS_BYTES = LDS_STG + 8192;

struct Args {
    const float *x, *c, *w_ada, *b_ada, *g_ffn1, *w1_gu, *w1_down, *g_mix, *w_in, *conv_w, *w_conv_proj, *w_attn_proj, *sinks, *w_out, *g_ffn2, *w2_gu, *w2_down, *g_final;
    float* out; unsigned char* ws; float inv_freq[32]; int ph_lo, ph_hi;
};
#define XB_TMO      128
#define XB_XCNT(j)  (256  + 64 * (j))
#define XB_XSUB(j)  (1280 + 64 * (j))
#define XB_XGEN(j)  (2304 + 64 * (j))
#define XB_TOP      3328
#define XB_TOPGEN   3392
#define XCD_BAR_WORDS 3456
#define XB_SPIN_CAP (1u << 18)

__device__ __forceinline__ unsigned xb_ld(unsigned* p)              { return __hip_atomic_load(p, __ATOMIC_RELAXED, __HIP_MEMORY_SCOPE_AGENT); }
__device__ __forceinline__ unsigned xb_add(unsigned* p, unsigned v) { return __hip_atomic_fetch_add(p, v, __ATOMIC_RELAXED, __HIP_MEMORY_SCOPE_AGENT); }
__device__ __forceinline__ unsigned xb_xcc_id() { return (unsigned)__builtin_amdgcn_s_getreg((3 << 11) | 20) & 0xFu; }
#define XB_SPIN(cond, bar) do { unsigned _sp = 0; while (cond) { __builtin_amdgcn_s_sleep(1); \
    if ((++_sp & 255u) == 0u) { if (xb_ld(&(bar)[XB_TMO])) break; if (_sp > XB_SPIN_CAP) { atomicAdd(&(bar)[XB_TMO], 1u); break; } } } } while (0)

struct XcdBarrier {
    unsigned* bar; unsigned x;
    volatile LAS unsigned* st;
};

__device__ __forceinline__ XcdBarrier xcd_barrier_post(unsigned* bar, volatile LAS unsigned* st) {
    XcdBarrier b; b.bar = bar; b.x = xb_xcc_id(); b.st = st;
    if (threadIdx.x == 0) (void)xb_add(&bar[XB_XCNT(b.x)], 1u);
    return b;
}
__device__ __forceinline__ void xcd_barrier_complete(unsigned* bar, unsigned x, unsigned& nloc, unsigned& nx) {
    const unsigned G = gridDim.x * gridDim.y * gridDim.z;
    unsigned sum, cnt, mine, sp = 0u;
    for (;;) {
        sum = 0u; cnt = 0u; mine = 0u;
#pragma unroll
        for (unsigned j = 0; j < 16; ++j) { const unsigned c = xb_ld(&bar[XB_XCNT(j)]); sum += c; cnt += (c > 0u) ? 1u : 0u; mine = (j == x) ? c : mine; }
        if (sum == G) break;
        __builtin_amdgcn_s_sleep(1);
        if ((++sp & 255u) == 0u) { if (xb_ld(&bar[XB_TMO])) break; if (sp > XB_SPIN_CAP) { atomicAdd(&bar[XB_TMO], 1u); break; } }
    }
    nloc = mine > 0u ? mine : 1u; nx = cnt > 0u ? cnt : 1u;
}

__device__ __forceinline__ void xcd_barrier(const XcdBarrier& b) {
    asm volatile("s_waitcnt vmcnt(0)" ::: "memory");
    __syncthreads();
    if (threadIdx.x == 0) {
        unsigned* bar = b.bar;
        __builtin_amdgcn_s_waitcnt(0);
        unsigned nloc = b.st[0], nx = b.st[1];
        if (nloc == 0u) { xcd_barrier_complete(bar, b.x, nloc, nx); b.st[0] = nloc; b.st[1] = nx; }
        const unsigned old = xb_add(&bar[XB_XSUB(b.x)], 1u);
        const unsigned gen = old / nloc;
        if (old + 1u == (gen + 1u) * nloc) {
            __builtin_amdgcn_fence(__ATOMIC_RELEASE, "agent");
            asm volatile("s_waitcnt vmcnt(0)" ::: "memory");
            const unsigned og = xb_add(&bar[XB_TOP], 1u);
            const unsigned tg = og / nx;
            if (og + 1u == (tg + 1u) * nx) xb_add(&bar[XB_TOPGEN], 1u);
            else XB_SPIN(xb_ld(&bar[XB_TOPGEN]) == tg, bar);
            __builtin_amdgcn_fence(__ATOMIC_ACQUIRE, "agent");
            xb_add(&bar[XB_XGEN(b.x)], 1u);
            asm volatile("s_waitcnt vmcnt(0)" ::: "memory");
        } else {
            XB_SPIN(xb_ld(&bar[XB_XGEN(b.x)]) == gen, bar);
            __builtin_amdgcn_fence(__ATOMIC_ACQUIRE, "agent");
            asm volatile("s_waitcnt vmcnt(0)" ::: "memory");
        }
    }
    __syncthreads();
}

namespace pg8 {
typedef unsigned u32x2 __attribute__((ext_vector_type(2)));
typedef float f32x16 __attribute__((ext_vector_type(16)));
__device__ __forceinline__ u32x4 pack8(const f32x4 a, const f32x4 b) { u32x4 w; w.x = cvt_pk_bf16(a[0], a[1]); w.y = cvt_pk_bf16(a[2], a[3]); w.z = cvt_pk_bf16(b[0], b[1]); w.w = cvt_pk_bf16(b[2], b[3]); return w; }
__device__ __forceinline__ void unpack8(const u32x4 w, f32x4& a, f32x4& b) {
    a[0] = __uint_as_float(w.x << 16); a[1] = __uint_as_float(w.x & 0xffff0000u); a[2] = __uint_as_float(w.y << 16); a[3] = __uint_as_float(w.y & 0xffff0000u);
    b[0] = __uint_as_float(w.z << 16); b[1] = __uint_as_float(w.z & 0xffff0000u); b[2] = __uint_as_float(w.w << 16); b[3] = __uint_as_float(w.w & 0xffff0000u);
}
__device__ __forceinline__ float sigm(float v) { return __builtin_amdgcn_rcpf(1.f + __expf(-v)); }
__device__ __forceinline__ float rstd_from(const float* ssq, int row) {
    const f32x4* p = (const f32x4*)(ssq + (size_t)row * 16);
    const f32x4 s = (p[0] + p[1]) + (p[2] + p[3]);
    return __builtin_amdgcn_rsqf(((s[0] + s[1]) + (s[2] + s[3])) * (1.0f / DM) + RMS_EPS);
}
constexpr int EPI_SCR_BYTES = 17408;
__device__ __forceinline__ void epi_prefetch(PG8_LAS unsigned char* scr, const float* ssq, const float* bias_tile, const Unit& u, int wid, int lane) {
    unsigned lo = (unsigned)lane * 16u; asm volatile("" : "+v"(lo));
    const char* src = (const char*)(ssq + (size_t)u.pm * BM * 16 + wid * 512);
#pragma unroll
    for (int j = 0; j < 2; ++j) __builtin_amdgcn_global_load_lds((const unsigned*)(src + j * 1024 + lo), (PG8_LAS unsigned*)(scr + (wid * 2 + j) * 1024), 16, 0, 0);
    if (wid == 0) __builtin_amdgcn_global_load_lds((const unsigned*)((const char*)bias_tile + lo), (PG8_LAS unsigned*)(scr + 16384), 16, 0, 0);
}
__device__ __forceinline__ float rstd_lds(const PG8_LAS unsigned char* scr, int lrow) {
    const PG8_LAS f32x4* p = (const PG8_LAS f32x4*)(scr + lrow * 64);
    const f32x4 s = (p[0] + p[1]) + (p[2] + p[3]);
    return __builtin_amdgcn_rsqf(((s[0] + s[1]) + (s[2] + s[3])) * (1.0f / DM) + RMS_EPS);
}
#define EPI_LROW (ai * HALF + wr * 64 + m * 16 + fr)
__device__ __forceinline__ void store_lines(PG8_LAS unsigned char* stg, const u32x4 P0, const u32x4 P1, int fr, int fq, bf16_t* seg0, int pitch) {
    const int ln = fq * 16 + fr;
#pragma unroll
    for (int h = 0; h < 2; ++h) {
        if ((fr >> 3) == h) { *(PG8_LAS u32x4*)(stg + (fr & 7) * 128 + fq * 16) = P0; *(PG8_LAS u32x4*)(stg + (fr & 7) * 128 + 64 + fq * 16) = P1; }
        __builtin_amdgcn_wave_barrier(); asm volatile("" ::: "memory");
        const u32x4 v = *(const PG8_LAS u32x4*)(stg + ln * 16);
        __builtin_amdgcn_wave_barrier(); asm volatile("" ::: "memory");
        *(u32x4*)(seg0 + (size_t)(8 * h + (ln >> 3)) * pitch + (ln & 7) * 8) = v; }
}
#define EPI_ROWS _Pragma("unroll") for (int ai = 0; ai < 2; ++ai) _Pragma("unroll") for (int m = 0; m < 4; ++m)
#define EPI_ROW (u.pm * BM + ai * HALF + wr * 64 + m * 16 + fr)

template <bool NORM> struct EpiGU {
    static constexpr bool PERM = true, AFTER_DRAIN = false, DUAL = false, PREFETCH = NORM, AIL = false; static constexpr int EPI_VM = 8;
    bf16_t* act; const float* ssq; const float* bias; PG8_LAS unsigned char* scr;
    __device__ __forceinline__ void prefetch(const Unit& u, int wid, int lane) const { epi_prefetch(scr, ssq, bias + (size_t)(u.pm >> 5) * NGU + u.pn * BM, u, wid, lane); }
    __device__ __forceinline__ void operator()(const f32x4 (&acc)[2][2][4][2], const Unit& u, int wr, int wc, int fr, int fq) const {
        asm volatile("" : "+v"(fr), "+v"(fq));
        const int b = u.pm >> 5, tcol = wc * 32 + fq * 8;
        f32x4 ba0 = {0.f, 0.f, 0.f, 0.f}, ba1 = ba0, bb0 = ba0, bb1 = ba0;
        if (NORM) { const PG8_LAS float* bp = (const PG8_LAS float*)(scr + 16384) + tcol; ba0 = *(const PG8_LAS f32x4*)bp; ba1 = *(const PG8_LAS f32x4*)(bp + 4); bb0 = *(const PG8_LAS f32x4*)(bp + HALF); bb1 = *(const PG8_LAS f32x4*)(bp + HALF + 4); }
        float rsv[2][4];
        if (NORM) { EPI_ROWS { rsv[ai][m] = rstd_lds(scr, EPI_LROW); asm volatile("" : "+v"(rsv[ai][m]) :: "memory"); } }
        EPI_ROWS { const int row = EPI_ROW;
            f32x4 a0 = acc[ai][0][m][0], a1 = acc[ai][0][m][1], b0 = acc[ai][1][m][0], b1 = acc[ai][1][m][1];
            if (NORM) { const float rs = rsv[ai][m]; a0 = a0 * rs + ba0; a1 = a1 * rs + ba1; b0 = b0 * rs + bb0; b1 = b1 * rs + bb1; }
            f32x4 o0, o1;
#pragma unroll
            for (int i = 0; i < 4; ++i) { o0[i] = a0[i] * sigm(a0[i]) * b0[i]; o1[i] = a1[i] * sigm(a1[i]) * b1[i]; }
            *(u32x4*)(act + (size_t)(row >> 1) * (2 * DFF) + (u.pn * 4 + wc) * 64 + (row & 1) * 32 + fq * 8) = pack8(o0, o1); }
    }
};

template <bool HALFG, bool XS, bool XOLD16, bool AIL_> struct EpiRes {
    static constexpr bool PERM = true, AFTER_DRAIN = false, DUAL = false, PREFETCH = false, AIL = AIL_;
    const void* xold; bf16_t* xnew; const float* gate; bf16_t* xs; const float* gcol; const float* scm; float* ssq; PG8_LAS unsigned char* stg;
    __device__ __forceinline__ void operator()(const f32x4 (&acc)[2][2][4][2], const Unit& u, int wr, int wc, int fr, int fq) const {
        asm volatile("" : "+v"(fr), "+v"(fq));
        const int b = u.pm >> 5, col0 = u.pn * BM + wc * 64 + fq * 8;
        PG8_LAS unsigned char* st = stg + (wr * 4 + wc) * 1024;
        f32x4 gv[2][2], cs[2][2];
#pragma unroll
        for (int bj = 0; bj < 2; ++bj)
#pragma unroll
            for (int n = 0; n < 2; ++n) { const int c = col0 + bj * 32 + 4 * n; gv[bj][n] = *(const f32x4*)(gate + (size_t)b * NMODC + c) * (HALFG ? 0.5f : 1.0f);
                cs[bj][n] = (f32x4){0.f, 0.f, 0.f, 0.f}; if (XS) cs[bj][n] = *(const f32x4*)(gcol + c) * (*(const f32x4*)(scm + (size_t)b * NMODC + c) + 1.0f); }
        u32x4 c16[2], n16[2]; f32x4 c32[2][2], n32[2][2];
#define RES_LOAD(D16, D32, r_) do { const size_t ro_ = (size_t)(u.pm * BM + ((r_) >> 2) * HALF + wr * 64 + ((r_) & 3) * 16 + fr) * DM + col0; _Pragma("unroll") for (int bj = 0; bj < 2; ++bj) { \
            if (XOLD16) D16[bj] = *(const u32x4*)((const bf16_t*)xold + ro_ + bj * 32); else { D32[bj][0] = *(const f32x4*)((const float*)xold + ro_ + bj * 32); D32[bj][1] = *(const f32x4*)((const float*)xold + ro_ + bj * 32 + 4); } } } while (0)
        RES_LOAD(c16, c32, 0);
#pragma unroll
        for (int r = 0; r < 8; ++r) { const int ai = r >> 2, m = r & 3; const int row = EPI_ROW; float sq = 0.f;
            if (r < 7) RES_LOAD(n16, n32, r + 1);
            u32x4 pn_[2], ps_[2];
#pragma unroll
            for (int bj = 0; bj < 2; ++bj) {
                f32x4 o0, o1;
                if (XOLD16) unpack8(c16[bj], o0, o1); else { o0 = c32[bj][0]; o1 = c32[bj][1]; }
                const f32x4 v0 = o0 + gv[bj][0] * acc[ai][bj][m][0], v1 = o1 + gv[bj][1] * acc[ai][bj][m][1];
                pn_[bj] = pack8(v0, v1);
                sq += ((v0[0] * v0[0] + v0[1] * v0[1]) + (v0[2] * v0[2] + v0[3] * v0[3])) + ((v1[0] * v1[0] + v1[1] * v1[1]) + (v1[2] * v1[2] + v1[3] * v1[3]));
                if (XS) ps_[bj] = pack8(v0 * cs[bj][0], v1 * cs[bj][1]); }
            { const size_t seg = (size_t)(row - fr) * DM + u.pn * BM + wc * 64;
              store_lines(st, pn_[0], pn_[1], fr, fq, xnew + seg, DM);
              if (XS) store_lines(st, ps_[0], ps_[1], fr, fq, xs + seg, DM); }
            sq += __shfl_xor(sq, 16); sq += __shfl_xor(sq, 32);
            if (fq == 0) ssq[(size_t)row * 16 + u.pn * 4 + wc] = sq;
#pragma unroll
            for (int bj = 0; bj < 2; ++bj) { c16[bj] = n16[bj]; c32[bj][0] = n32[bj][0]; c32[bj][1] = n32[bj][1]; } }
#undef RES_LOAD
    }
};

struct EpiIn {
    static constexpr bool PERM = true, AFTER_DRAIN = false, DUAL = false, PREFETCH = true, AIL = false; static constexpr int EPI_VM = 8;
    PG8_LAS unsigned char* scr; PG8_LAS unsigned char* stg;
    __device__ __forceinline__ void prefetch(const Unit& u, int wid, int lane) const { epi_prefetch(scr, ssq, bias + (size_t)(u.pm >> 5) * DIN + u.pn * BM, u, wid, lane); }
    const float* ssq; const float* bias; const float* cosT; const float* sinT; bf16_t *BG, *CU, *Q, *K, *V, *SZC, *SZA;
    __device__ __forceinline__ void operator()(const f32x4 (&acc)[2][2][4][2], const Unit& u, int wr, int wc, int fr, int fq) const {
        asm volatile("" : "+v"(fr), "+v"(fq));
        const int b = u.pm >> 5, tcol = wc * 32 + fq * 8, pn = u.pn;
        const PG8_LAS float* bp = (const PG8_LAS float*)(scr + 16384) + tcol;
        const f32x4 ba0 = *(const PG8_LAS f32x4*)bp, ba1 = *(const PG8_LAS f32x4*)(bp + 4), bb0 = *(const PG8_LAS f32x4*)(bp + HALF), bb1 = *(const PG8_LAS f32x4*)(bp + HALF + 4);
        int mode, pitch, c0, c1; bf16_t* dst;
        if (pn < 4)       { mode = 0; dst = BG;  pitch = DM;  c0 = pn * BM + wc * 64 + fq * 8; c1 = c0 + 32; }
        else if (pn < 12) { mode = 1; dst = CU;  pitch = DM;  c0 = (pn - 4) * HALF + tcol; c1 = c0; }
        else if (pn < 16) { mode = 2; dst = Q;   pitch = DM;  c0 = (4 * (pn - 12) + wc) * 64 + fq * 8; c1 = c0 + 32; }
        else if (pn < 17) { mode = 2; dst = K;   pitch = 256; c0 = wc * 64 + fq * 8; c1 = c0 + 32; }
        else if (pn < 18) { mode = 0; dst = V;   pitch = 256; c0 = wc * 64 + fq * 8; c1 = c0 + 32; }
        else              { mode = 3; dst = SZC; pitch = DM;  c0 = (pn - 18) * HALF + tcol; c1 = c0; }
        float rsv[2][4];
        EPI_ROWS { rsv[ai][m] = rstd_lds(scr, EPI_LROW); asm volatile("" : "+v"(rsv[ai][m]) :: "memory"); }
#define ROPE_LOAD(C0, C1, S0, S1, r_) do { const int pos_ = (u.pm * BM + ((r_) >> 2) * HALF + wr * 64 + ((r_) & 3) * 16 + fr) & (SEQ - 1); const float* cp_ = cosT + pos_ * 32 + fq * 8; const float* sp_ = sinT + pos_ * 32 + fq * 8; \
            C0 = *(const f32x4*)cp_; C1 = *(const f32x4*)(cp_ + 4); S0 = *(const f32x4*)sp_; S1 = *(const f32x4*)(sp_ + 4); } while (0)
#pragma unroll
        for (int r = 0; r < 8; ++r) { const int ai = r >> 2, m = r & 3; const int row = EPI_ROW; const float rs = rsv[ai][m];
            f32x4 a0 = acc[ai][0][m][0] * rs + ba0, a1 = acc[ai][0][m][1] * rs + ba1, b0 = acc[ai][1][m][0] * rs + bb0, b1 = acc[ai][1][m][1] * rs + bb1;
            bf16_t* rp = dst + (size_t)row * pitch;
            if (mode == 1) { *(u32x4*)(rp + c0) = pack8(a0 * b0, a1 * b1); }
            else if (mode == 3) {
#pragma unroll
                for (int i = 0; i < 4; ++i) {
                    const float ea0 = __expf(-a0[i]), ea1 = __expf(-a1[i]), eb0 = __expf(-b0[i]), eb1 = __expf(-b1[i]);
                    a0[i] = (1.f + eb0) * __builtin_amdgcn_rcpf(1.f + ea0); a1[i] = (1.f + eb1) * __builtin_amdgcn_rcpf(1.f + ea1); b0[i] = __builtin_amdgcn_rcpf(1.f + eb0); b1[i] = __builtin_amdgcn_rcpf(1.f + eb1); }
                { const size_t po = (size_t)(row >> 1) * (2 * DM) + ((pn - 18) * 4 + wc) * 64 + (row & 1) * 32 + fq * 8;
                  *(u32x4*)(SZC + po) = pack8(a0, a1); *(u32x4*)(SZA + po) = pack8(b0, b1); } }
            else {
                if (mode == 2) { f32x4 cA, cB, sA, sB; ROPE_LOAD(cA, cB, sA, sB, r); const f32x4 x0 = a0, x1 = a1, y0 = b0, y1 = b1;
                    a0 = x0 * cA - y0 * sA; a1 = x1 * cB - y1 * sB; b0 = y0 * cA + x0 * sA; b1 = y1 * cB + x1 * sB; }
                store_lines(stg + (wr * 4 + wc) * 1024, pack8(a0, a1), pack8(b0, b1), fr, fq, dst + (size_t)(row - fr) * pitch + (c0 - fq * 8), pitch); } }
#undef ROPE_LOAD
    }
};

struct EpiDual {
    static constexpr bool PERM = true, AFTER_DRAIN = false, DUAL = true, PREFETCH = false, AIL = false; static constexpr int EPI_VM = 16;
    const bf16_t* rz; const bf16_t* sa; bf16_t* mg; PG8_LAS unsigned char* stg;
    __device__ __forceinline__ void mid(f32x4 (&acc)[2][2][4][2], const Unit& u, int wr, int wc, int fr, int fq) const {
        asm volatile("" : "+v"(fr), "+v"(fq));
        const int col0 = u.pn * BM + wc * 64 + fq * 8;
        EPI_ROWS { const int row = EPI_ROW;
#pragma unroll
            for (int bj = 0; bj < 2; ++bj) { const size_t off = (size_t)(row >> 1) * (2 * DM) + (u.pn * 8 + wc * 2 + bj) * 64 + (row & 1) * 32 + fq * 8; f32x4 g0, g1; unpack8(*(const u32x4*)(rz + off), g0, g1);
                acc[ai][bj][m][0] *= g0; acc[ai][bj][m][1] *= g1; } }
    }
    __device__ __forceinline__ void operator()(const f32x4 (&acc)[2][2][4][2], const Unit& u, int wr, int wc, int fr, int fq) const {
        asm volatile("" : "+v"(fr), "+v"(fq));
        const int col0 = u.pn * BM + wc * 64 + fq * 8;
        u32x4 cg[2], ng[2];
#define SA_LOAD(D, r_) do { const int rw_ = u.pm * BM + ((r_) >> 2) * HALF + wr * 64 + ((r_) & 3) * 16 + fr; const size_t ro_ = (size_t)(rw_ >> 1) * (2 * DM) + (u.pn * 8 + wc * 2) * 64 + (rw_ & 1) * 32 + fq * 8; D[0] = *(const u32x4*)(sa + ro_); D[1] = *(const u32x4*)(sa + ro_ + 64); } while (0)
        SA_LOAD(cg, 0);
#pragma unroll
        for (int r = 0; r < 8; ++r) { const int ai = r >> 2, m = r & 3; const int row = EPI_ROW;
            if (r < 7) SA_LOAD(ng, r + 1);
            u32x4 pm_[2];
#pragma unroll
            for (int bj = 0; bj < 2; ++bj) { f32x4 g0, g1; unpack8(cg[bj], g0, g1); pm_[bj] = pack8(g0 * acc[ai][bj][m][0], g1 * acc[ai][bj][m][1]); }
            store_lines(stg + (wr * 4 + wc) * 1024, pm_[0], pm_[1], fr, fq, mg + (size_t)(row - fr) * DM + u.pn * BM + wc * 64, DM);
            cg[0] = ng[0]; cg[1] = ng[1]; }
#undef SA_LOAD
    }
};
}
using pg8::bf16_t; using pg8::f32x4; using pg8::u32x4; using pg8::u32x2; using pg8::bf16x8; using pg8::f32x16;

__device__ __forceinline__ float wave_sum(float v) {
#pragma unroll
    for (int o = 1; o < 64; o <<= 1) v += __shfl_xor(v, o);
    return v;
}
__device__ __forceinline__ unsigned f2bf(float f) { unsigned u = __builtin_bit_cast(unsigned, f); return (u + 0x7fffu + ((u >> 16) & 1u)) >> 16; }
__device__ __forceinline__ unsigned pk2(float lo, float hi) { return f2bf(lo) | (f2bf(hi) << 16); }

__device__ __forceinline__ int wcperm(int n0) { const int t = n0 & 255; return (n0 & ~255) + 128 * ((t >> 5) & 1) + 32 * (t >> 6); }
__device__ __forceinline__ int dest_row(int kind, int n0) {
    if (kind == 1) { const int half = n0 >= DFF, j = half ? n0 - DFF : n0; return 256 * (j >> 7) + 128 * half + (j & 127); }
    if (kind == 2) {
        if (n0 < 1024) return wcperm(n0);
        if (n0 < 3072) { const int half = n0 >= 2048, j = (n0 - 1024) & 1023; return 1024 + 256 * (j >> 7) + 128 * half + (j & 127); }
        if (n0 < 4352) { const int base = n0 < 4096 ? 3072 : 4096, j = n0 - base, head = j >> 6, dd = j & 63; return base + 256 * (head >> 2) + 128 * (dd >> 5) + 32 * (head & 3) + (dd & 31); }
        if (n0 >= 4608) { const int half = n0 >= 5632, j = (n0 - 4608) & 1023; return 4608 + 256 * (j >> 7) + 128 * half + (j & 127); }
        return wcperm(n0);
    }
    if (kind == 3) return wcperm(n0);
    return n0;
}
__device__ __forceinline__ void p0_transpose_item(const float* W, int K, int N, bf16_t* WT, int kind, LAS float* scr, int item, int lane) {
    const int nblk = N / 32, kb = item / nblk, nb = item % nblk, k0 = 64 * kb, n0 = 32 * nb, dr0 = dest_row(kind, n0);
#pragma unroll 8
    for (int i = 0; i < 32; ++i) { const int kk = 2 * i + (lane >> 5); scr[kk * 33 + (lane & 31)] = W[(size_t)(k0 + kk) * N + n0 + (lane & 31)]; }
    asm volatile("s_waitcnt lgkmcnt(0)" ::: "memory");
    const int c = lane & 7;
#pragma unroll
    for (int j = 0; j < 4; ++j) { const int n = (lane >> 3) + 8 * j; const LAS float* s = scr + (8 * c) * 33 + n;
        u32x4 o; o.x = pk2(s[0 * 33], s[1 * 33]); o.y = pk2(s[2 * 33], s[3 * 33]); o.z = pk2(s[4 * 33], s[5 * 33]); o.w = pk2(s[6 * 33], s[7 * 33]);
        *(u32x4*)(WT + (size_t)(dr0 + n) * K + k0 + 8 * c) = o; }
    asm volatile("s_waitcnt lgkmcnt(0)" ::: "memory");
}

__device__ __forceinline__ void p0_prologue(const Args& A, LAS unsigned char* lds, int tid, int lane, int wave) {
    unsigned char* ws = A.ws;
    float* mods = (float*)(ws + WS_MODS);
    {
        LAS float* sc = (LAS float*)lds; LAS float* red = (LAS float*)(lds + 16384);
        for (int i = tid; i < BATCH * DM; i += 512) { const float v = A.c[i]; sc[i] = v / (1.f + expf(-v)); }
        __syncthreads();
        for (int item = blockIdx.x; item < NMODC / 64; item += gridDim.x) {
            const float* wp = A.w_ada + (size_t)(wave * 128) * NMODC + item * 64 + lane;
            float a0 = 0.f, a1 = 0.f, a2 = 0.f, a3 = 0.f;
#pragma unroll 8
            for (int k = 0; k < 128; ++k) { const float w = wp[(size_t)k * NMODC]; const int kk = wave * 128 + k;
                a0 += sc[kk] * w; a1 += sc[DM + kk] * w; a2 += sc[2 * DM + kk] * w; a3 += sc[3 * DM + kk] * w; }
            red[(wave * 4 + 0) * 64 + lane] = a0; red[(wave * 4 + 1) * 64 + lane] = a1; red[(wave * 4 + 2) * 64 + lane] = a2; red[(wave * 4 + 3) * 64 + lane] = a3;
            __syncthreads();
            if (tid < 256) { const int b = tid >> 6, col = tid & 63; float s = A.b_ada[item * 64 + col];
#pragma unroll
                for (int w = 0; w < 8; ++w) s += red[(w * 4 + b) * 64 + col];
                mods[(size_t)b * NMODC + item * 64 + col] = s; }
            __syncthreads();
        }
        __syncthreads();
    }
    {
        float* cosT = (float*)(ws + WS_COS); float* sinT = (float*)(ws + WS_SIN);
        for (int e = blockIdx.x * 512 + tid; e < SEQ * 32; e += gridDim.x * 512) {
            const int pos = e >> 5, i = e & 31; const float angf = (float)pos * A.inv_freq[i];
            const double a = (double)angf, kq = rint(a * 0.63661977236758134308), r = fma(-kq, 6.123233995736766e-17, fma(-kq, 1.5707963267948966, a)), r2 = r * r;
            double sn = -1.0 / 1307674368000.0; sn = sn * r2 + 1.0 / 6227020800.0; sn = sn * r2 - 1.0 / 39916800.0; sn = sn * r2 + 1.0 / 362880.0; sn = sn * r2 - 1.0 / 5040.0; sn = sn * r2 + 1.0 / 120.0; sn = sn * r2 - 1.0 / 6.0; sn = sn * r2 * r + r;
            double cs = 1.0 / 20922789888000.0; cs = cs * r2 - 1.0 / 87178291200.0; cs = cs * r2 + 1.0 / 479001600.0; cs = cs * r2 - 1.0 / 3628800.0; cs = cs * r2 + 1.0 / 40320.0; cs = cs * r2 - 1.0 / 720.0; cs = cs * r2 + 1.0 / 24.0; cs = cs * r2 - 0.5; cs = cs * r2 + 1.0;
            const int qd = ((int)kq) & 3;
            const double sv = (qd == 0) ? sn : (qd == 1) ? cs : (qd == 2) ? -sn : -cs;
            const double cv = (qd == 0) ? cs : (qd == 1) ? -sn : (qd == 2) ? -cs : sn;
            cosT[e] = (float)cv; sinT[e] = (float)sv;
        }
    }
    {
        LAS float* scr = (LAS float*)(lds + wave * 16384);
        const int gw = blockIdx.x * 8 + wave, NGW = gridDim.x * 8;
        constexpr int I_GU = (DM / 64) * (NGU / 32), I_DN = (DFF / 64) * (DM / 32), I_IN = (DM / 64) * (DIN / 32), I_SQ = (DM / 64) * (DM / 32);
        constexpr int NITEMS = 2 * I_GU + 2 * I_DN + I_IN + 3 * I_SQ;
        for (int it = gw; it < NITEMS; it += NGW) {
            int r = it;
            if (r < I_GU) { p0_transpose_item(A.w1_gu, DM, NGU, (bf16_t*)(ws + WS_W1GU), 1, scr, r, lane); continue; } r -= I_GU;
            if (r < I_DN) { p0_transpose_item(A.w1_down, DFF, DM, (bf16_t*)(ws + WS_W1DN), 3, scr, r, lane); continue; } r -= I_DN;
            if (r < I_IN) { p0_transpose_item(A.w_in, DM, DIN, (bf16_t*)(ws + WS_WIN), 2, scr, r, lane); continue; } r -= I_IN;
            if (r < I_SQ) { p0_transpose_item(A.w_conv_proj, DM, DM, (bf16_t*)(ws + WS_WC), 3, scr, r, lane); continue; } r -= I_SQ;
            if (r < I_SQ) { p0_transpose_item(A.w_attn_proj, DM, DM, (bf16_t*)(ws + WS_WA), 3, scr, r, lane); continue; } r -= I_SQ;
            if (r < I_SQ) { p0_transpose_item(A.w_out, DM, DM, (bf16_t*)(ws + WS_WO), 3, scr, r, lane); continue; } r -= I_SQ;
            if (r < I_GU) { p0_transpose_item(A.w2_gu, DM, NGU, (bf16_t*)(ws + WS_W2GU), 1, scr, r, lane); continue; } r -= I_GU;
            p0_transpose_item(A.w2_down, DFF, DM, (bf16_t*)(ws + WS_W2DN), 3, scr, r, lane);
        }
    }
}

__device__ __forceinline__ void p1_rows(const Args& A, int lane, int wave) {
    unsigned char* ws = A.ws; const float* mods = (const float*)(ws + WS_MODS);
    const int gw = blockIdx.x * 8 + wave, NGW = gridDim.x * 8;
    bf16_t* HB = (bf16_t*)(ws + WS_HB);
    f32x4 nx[4];
    if (gw < M) {
#pragma unroll
        for (int j = 0; j < 4; ++j) nx[j] = ((const f32x4*)(A.x + (size_t)gw * DM) + lane)[64 * j]; }
    for (int m = gw; m < M; m += NGW) {
        const int b = m >> 13;
        f32x4 v[4]; float s = 0.f;
#pragma unroll
        for (int j = 0; j < 4; ++j) v[j] = nx[j];
        if (m + NGW < M) {
#pragma unroll
            for (int j = 0; j < 4; ++j) nx[j] = ((const f32x4*)(A.x + (size_t)(m + NGW) * DM) + lane)[64 * j]; }
#pragma unroll
        for (int j = 0; j < 4; ++j) s += (v[j][0] * v[j][0] + v[j][1] * v[j][1]) + (v[j][2] * v[j][2] + v[j][3] * v[j][3]);
        const float rstd = 1.0f / sqrtf(wave_sum(s) * (1.0f / DM) + RMS_EPS);
        u32x2* o8 = (u32x2*)(HB + (size_t)m * DM) + lane;
#pragma unroll
        for (int j = 0; j < 4; ++j) { const int c = 4 * lane + 256 * j;
            const f32x4 g = *(const f32x4*)(A.g_ffn1 + c), sc = *(const f32x4*)(mods + (size_t)b * NMODC + MOD_SC1 * DM + c), sh = *(const f32x4*)(mods + (size_t)b * NMODC + MOD_SH1 * DM + c);
            const f32x4 h = (v[j] * rstd) * g * (sc + 1.0f) + sh;
            u32x2 w; w.x = pg8::cvt_pk_bf16(h[0], h[1]); w.y = pg8::cvt_pk_bf16(h[2], h[3]); o8[64 * j] = w; }
    }
    for (int it = gw; it < DIN + NGU; it += NGW) {
        const bool second = it >= DIN; const int dr = second ? it - DIN : it;
        const bf16_t* wrow = (const bf16_t*)(ws + (second ? WS_W2GU : WS_WIN)) + (size_t)dr * DM;
        const float* sh = mods + (second ? MOD_SH3 : MOD_SH2) * DM;
        float a0 = 0.f, a1 = 0.f, a2 = 0.f, a3 = 0.f;
#pragma unroll
        for (int j = 0; j < 2; ++j) { const int k = 8 * lane + 512 * j; f32x4 wa, wb; pg8::unpack8(*(const u32x4*)(wrow + k), wa, wb);
#define BDOT(acc_, bb) { const f32x4 s0 = *(const f32x4*)(sh + (size_t)(bb) * NMODC + k), s1 = *(const f32x4*)(sh + (size_t)(bb) * NMODC + k + 4); \
            acc_ += ((wa[0] * s0[0] + wa[1] * s0[1]) + (wa[2] * s0[2] + wa[3] * s0[3])) + ((wb[0] * s1[0] + wb[1] * s1[1]) + (wb[2] * s1[2] + wb[3] * s1[3])); }
            BDOT(a0, 0) BDOT(a1, 1) BDOT(a2, 2) BDOT(a3, 3)
#undef BDOT
        }
        a0 = wave_sum(a0); a1 = wave_sum(a1); a2 = wave_sum(a2); a3 = wave_sum(a3);
        if (lane == 0) { float* bo = (float*)(ws + (second ? WS_BIAS3 : WS_BIAS2)); const int N = second ? NGU : DIN;
            bo[dr] = a0; bo[N + dr] = a1; bo[2 * N + dr] = a2; bo[3 * N + dr] = a3; }
    }
}

__device__ __forceinline__ void p5_conv(const Args& A, int lane, int wave, bf16_t* Gout) {
    unsigned char* ws = A.ws; const bf16_t* BG = (const bf16_t*)(ws + WS_BG); const bf16_t* CU = (const bf16_t*)(ws + WS_CU);
    const int gw = blockIdx.x * 8 + wave, NGW = gridDim.x * 8;
    for (int wi = gw; wi < (M / 32) * 2; wi += NGW) {
        const int r0 = (wi >> 1) * 32, c0 = (wi & 1) * 512 + lane * 8;
        const f32x4 w0a = *(const f32x4*)(A.conv_w + c0), w0b = *(const f32x4*)(A.conv_w + c0 + 4), w1a = *(const f32x4*)(A.conv_w + DM + c0), w1b = *(const f32x4*)(A.conv_w + DM + c0 + 4),
                    w2a = *(const f32x4*)(A.conv_w + 2 * DM + c0), w2b = *(const f32x4*)(A.conv_w + 2 * DM + c0 + 4);
        f32x4 p2a = {0.f, 0.f, 0.f, 0.f}, p2b = p2a, p1a = p2a, p1b = p2a;
        if ((r0 & (SEQ - 1)) != 0) { pg8::unpack8(*(const u32x4*)(CU + (size_t)(r0 - 2) * DM + c0), p2a, p2b); pg8::unpack8(*(const u32x4*)(CU + (size_t)(r0 - 1) * DM + c0), p1a, p1b); }
        u32x4 cq[4], bq[4];
#pragma unroll
        for (int i = 0; i < 4; ++i) { const size_t off = (size_t)(r0 + i) * DM + c0; cq[i] = *(const u32x4*)(CU + off); bq[i] = *(const u32x4*)(BG + off); }
#pragma unroll
        for (int t = 0; t < 32; ++t) { const size_t off = (size_t)(r0 + t) * DM + c0;
            f32x4 ca, cb, ba, bb; pg8::unpack8(cq[t & 3], ca, cb); pg8::unpack8(bq[t & 3], ba, bb);
            if (t + 4 < 32) { const size_t offn = (size_t)(r0 + t + 4) * DM + c0; cq[t & 3] = *(const u32x4*)(CU + offn); bq[t & 3] = *(const u32x4*)(BG + offn); }
            const f32x4 oa = ba * ((w0a * p2a + w1a * p1a) + w2a * ca), ob = bb * ((w0b * p2b + w1b * p1b) + w2b * cb);
            *(u32x4*)(Gout + off) = pg8::pack8(oa, ob);
            p2a = p1a; p2b = p1b; p1a = ca; p1b = cb; }
    }
}

constexpr int KS_OFF = 0, KS_PITCH = 144, VS_OFF = 256 * KS_PITCH, VS_PITCH = 528, OS_OFF = VS_OFF + 64 * VS_PITCH, OS_PITCH = 144, OS_WAVE = 32 * OS_PITCH;
__device__ __forceinline__ void attn_unit(LAS unsigned char* lds, const bf16_t* Q, bf16_t* O, const bf16_t* Kb, const bf16_t* Vb, const float* sinks, int unit, int tid, int lane, int wid, int chain_ui) {
    const int n = unit & 63, g = (unit >> 6) & 3, b = unit >> 8;
    const int r0 = b * SEQ + n * 128;
    const int q = lane & 31, hi = lane >> 5, hq = wid >> 1, head = 4 * g + hq;
    bf16x8 Qf[2][4];
#pragma unroll
    for (int it = 0; it < 2; ++it) { const bf16_t* qp = Q + (size_t)(r0 + 32 * ((wid & 1) * 2 + it) + q) * DM + head * 64;
#pragma unroll
        for (int d0 = 0; d0 < 4; ++d0) Qf[it][d0] = *(const bf16x8*)(qp + 16 * d0 + 8 * hi); }
    const bool full = chain_ui <= 0; const int par = full ? 0 : (chain_ui & 1);
    const int ph0 = par * 128, ph1 = (par ^ 1) * 128;
    u32x4 kk[4], vv[4];
#pragma unroll
    for (int i = 0; i < 4; ++i) { const int t_ = tid + 512 * (i & 1), krl = t_ >> 3, ch = t_ & 7, h = (i < 2) ? 1 : 0;
        kk[i] = (u32x4){0u, 0u, 0u, 0u};
        if (h == 1 || (full && n > 0)) kk[i] = *(const u32x4*)(Kb + (size_t)(r0 - 128 + h * 128 + krl) * 256 + g * 64 + ch * 8); }
#pragma unroll
    for (int i = 0; i < 4; ++i) { const int t_ = tid + 512 * (i & 1), kvl = t_ & 127, c = t_ >> 7, h = (i < 2) ? 1 : 0;
        vv[i] = (u32x4){0u, 0u, 0u, 0u};
        if (h == 1 || (full && n > 0)) vv[i] = *(const u32x4*)(Vb + (size_t)(r0 - 128 + h * 128 + kvl) * 256 + g * 64 + c * 8); }
#pragma unroll
    for (int i = 0; i < 4; ++i) { const int t_ = tid + 512 * (i & 1), krl = t_ >> 3, ch = t_ & 7, h = (i < 2) ? 1 : 0;
        if (h == 1 || full) *(LAS u32x4*)(lds + KS_OFF + ((h ? ph1 : ph0) + krl) * KS_PITCH + ch * 16) = kk[i]; }
#pragma unroll
    for (int i = 0; i < 4; ++i) { const int t_ = tid + 512 * (i & 1), kvl = t_ & 127, c = t_ >> 7, h = (i < 2) ? 1 : 0;
        if (h == 1 || full) { LAS bf16_t* vp = (LAS bf16_t*)(lds + VS_OFF + (c * 8) * VS_PITCH + ((h ? ph1 : ph0) + kvl) * 2);
#pragma unroll
            for (int e = 0; e < 8; ++e) { const unsigned w = vv[i][e >> 1]; vp[e * (VS_PITCH / 2)] = (bf16_t)((e & 1) ? (w >> 16) : (w & 0xffffu)); } } }
    __syncthreads();
    const int ks = (q & 0x13) | ((q & 4) << 1) | ((q & 8) >> 1);
    const float sink = sinks[head];
#pragma unroll
    for (int it = 0; it < 2; ++it) {
        const int rb = (wid & 1) * 2 + it;
        f32x16 S[5];
#pragma unroll
        for (int j = 0; j < 5; ++j) {
#pragma unroll
            for (int r = 0; r < 16; ++r) S[j][r] = 0.f;
#pragma unroll
            for (int d0 = 0; d0 < 4; ++d0) { const bf16x8 Kf = *(const LAS bf16x8*)(lds + KS_OFF + ((((rb + j) >> 2) ? ph1 : ph0) + ((32 * (rb + j)) & 127) + ks) * KS_PITCH + (16 * d0 + 8 * hi) * 2);
                S[j] = __builtin_amdgcn_mfma_f32_32x32x16_bf16(Kf, Qf[it][d0], S[j], 0, 0, 0); } }
        float mx = -3.0e38f;
#pragma unroll
        for (int j = 0; j < 5; ++j) { const bool tile_ok = (n > 0) || (rb + j >= 4);
#pragma unroll
            for (int r = 0; r < 16; ++r) { const int off = 16 * (r >> 3) + 8 * hi + (r & 7), diff = 128 + q - 32 * j - off;
                bool ok = tile_ok; if (j == 0) ok = ok && (diff < 128); if (j == 4) ok = ok && (diff >= 0);
                const float sv = ok ? S[j][r] * 0.125f : -1e30f; S[j][r] = sv; mx = fmaxf(mx, sv); } }
        mx = fmaxf(mx, __shfl_xor(mx, 32)); mx = fmaxf(mx, sink);
        const float L2E = 1.4426950408889634f, mneg = -mx * L2E;
        float sum = 0.f;
#pragma unroll
        for (int j = 0; j < 5; ++j)
#pragma unroll
            for (int r = 0; r < 16; ++r) { const float pv = __builtin_amdgcn_exp2f(S[j][r] * L2E + mneg); S[j][r] = pv; sum += pv; }
        sum += __shfl_xor(sum, 32);
        const float inv = 1.0f / (sum + __builtin_amdgcn_exp2f((sink - mx) * L2E));
        f32x16 O0, O1;
#pragma unroll
        for (int r = 0; r < 16; ++r) { O0[r] = 0.f; O1[r] = 0.f; }
#pragma unroll
        for (int j = 0; j < 5; ++j)
#pragma unroll
            for (int st = 0; st < 2; ++st) {
                u32x4 pw; pw.x = pg8::cvt_pk_bf16(S[j][8 * st + 0], S[j][8 * st + 1]); pw.y = pg8::cvt_pk_bf16(S[j][8 * st + 2], S[j][8 * st + 3]);
                pw.z = pg8::cvt_pk_bf16(S[j][8 * st + 4], S[j][8 * st + 5]); pw.w = pg8::cvt_pk_bf16(S[j][8 * st + 6], S[j][8 * st + 7]);
                const bf16x8 Pf = __builtin_bit_cast(bf16x8, pw);
                const int kvoff = ((((rb + j) >> 2) ? ph1 : ph0) + ((32 * (rb + j)) & 127) + 16 * st + 8 * hi) * 2;
                const bf16x8 V0 = *(const LAS bf16x8*)(lds + VS_OFF + q * VS_PITCH + kvoff), V1 = *(const LAS bf16x8*)(lds + VS_OFF + (32 + q) * VS_PITCH + kvoff);
                O0 = __builtin_amdgcn_mfma_f32_32x32x16_bf16(V0, Pf, O0, 0, 0, 0); O1 = __builtin_amdgcn_mfma_f32_32x32x16_bf16(V1, Pf, O1, 0, 0, 0); }
        { LAS unsigned char* ost = lds + OS_OFF + wid * OS_WAVE;
#pragma unroll
          for (int r4 = 0; r4 < 4; ++r4) { const int d = 8 * r4 + 4 * hi;
            u32x2 w0, w1; w0.x = pg8::cvt_pk_bf16(O0[4 * r4] * inv, O0[4 * r4 + 1] * inv); w0.y = pg8::cvt_pk_bf16(O0[4 * r4 + 2] * inv, O0[4 * r4 + 3] * inv);
            w1.x = pg8::cvt_pk_bf16(O1[4 * r4] * inv, O1[4 * r4 + 1] * inv); w1.y = pg8::cvt_pk_bf16(O1[4 * r4 + 2] * inv, O1[4 * r4 + 3] * inv);
            *(LAS u32x2*)(ost + q * OS_PITCH + d * 2) = w0; *(LAS u32x2*)(ost + q * OS_PITCH + (32 + d) * 2) = w1; }
          __builtin_amdgcn_wave_barrier(); asm volatile("" ::: "memory");
          bf16_t* ob = O + (size_t)(r0 + 32 * rb) * DM + head * 64;
#pragma unroll
          for (int ps = 0; ps < 4; ++ps) { const int rr = 8 * ps + (lane >> 3), pc = lane & 7;
            const u32x4 v = *(const LAS u32x4*)(ost + rr * OS_PITCH + pc * 16);
            *(u32x4*)(ob + (size_t)rr * DM + pc * 8) = v; }
          __builtin_amdgcn_wave_barrier(); asm volatile("" ::: "memory"); }
    }
    __syncthreads();
}

__device__ __forceinline__ void p10_final(const Args& A, int lane, int wave, float* outp) {
    const float* ssq = (const float*)(A.ws + WS_SSQF); const bf16_t* X3 = (const bf16_t*)(A.ws + WS_X3);
    const int gw = blockIdx.x * 8 + wave, NGW = gridDim.x * 8;
    for (int m = gw; m < M; m += NGW) { const float rs = pg8::rstd_from(ssq, m);
#pragma unroll
        for (int j = 0; j < 2; ++j) { const int c = 8 * lane + 512 * j; f32x4 a, b; pg8::unpack8(*(const u32x4*)(X3 + (size_t)m * DM + c), a, b);
            *(f32x4*)(outp + (size_t)m * DM + c) = (a * rs) * *(const f32x4*)(A.g_final + c); *(f32x4*)(outp + (size_t)m * DM + c + 4) = (b * rs) * *(const f32x4*)(A.g_final + c + 4); } }
}

constexpr int N_PHASES = 11;
__global__ void __launch_bounds__(512, 2) mk_fwd(Args A) {
    extern __shared__ __attribute__((aligned(16))) unsigned char lds_raw[];
    LAS unsigned char* lds = (LAS unsigned char*)lds_raw;
    const int tid = threadIdx.x, lane = tid & 63, wave = __builtin_amdgcn_readfirstlane(tid >> 6);
    const int lo = A.ph_lo, hi = A.ph_hi, G = gridDim.x, cid = blockIdx.x;
    unsigned char* ws = A.ws;
    const float* mods = (const float*)(ws + WS_MODS);
    bf16_t* const RES = (bf16_t*)((unsigned char*)A.out + OUT_RES);
#define IN(k) (lo <= (k) && (k) < hi)
    if (tid < 2) ((LAS unsigned*)(lds + LDS_BARW))[tid] = 0u;
    __syncthreads();
    XcdBarrier bar; bar.bar = (unsigned*)(ws + WS_CTL); bar.x = 0; bar.st = nullptr;
    if (hi - lo > 1) bar = xcd_barrier_post((unsigned*)(ws + WS_CTL), (volatile LAS unsigned*)(lds + LDS_BARW));
#define SEAM(k) do { if (IN(k) && IN((k) + 1)) xcd_barrier(bar); } while (0)
    if (IN(0)) { p0_prologue(A, lds, tid, lane, wave); } SEAM(0);
    if (IN(1)) { p1_rows(A, lane, wave); } SEAM(1);
    if (IN(2)) { pg8::Gemm g{(const bf16_t*)(ws + WS_HB), (const bf16_t*)(ws + WS_W1GU), M, NGU, DM}; pg8::StaticOrder S; S.init(M, NGU, G, cid);
        pg8::EpiGU<false> E{(bf16_t*)(ws + WS_ACT1), nullptr, nullptr, nullptr};
        pg8::gemm_phase<pg8::EpiGU<false>, pg8::StaticOrder, true, true>(lds, g, S, E); } SEAM(2);
    if (IN(3)) { pg8::Gemm g{(const bf16_t*)(ws + WS_ACT1), (const bf16_t*)(ws + WS_W1DN), M, DM, DFF}; pg8::StaticOrder S; S.init(M, DM, G, cid);
        pg8::EpiRes<true, true, false, true> E{A.x, RES, mods + MOD_GT1 * DM, (bf16_t*)(ws + WS_HB), A.g_mix, mods + MOD_SC2 * DM, (float*)(ws + WS_SSQ2), lds + LDS_STG};
        pg8::gemm_phase<pg8::EpiRes<true, true, false, true>, pg8::StaticOrder, true, true>(lds, g, S, E); } SEAM(3);
    if (IN(4)) { pg8::Gemm g{(const bf16_t*)(ws + WS_HB), (const bf16_t*)(ws + WS_WIN), M, DIN, DM}; pg8::StaticOrder S; S.init(M, DIN, G, cid);
        pg8::EpiIn E{lds + LDS_SCR, lds + LDS_STG, (const float*)(ws + WS_SSQ2), (const float*)(ws + WS_BIAS2), (const float*)(ws + WS_COS), (const float*)(ws + WS_SIN),
                     (bf16_t*)(ws + WS_BG), (bf16_t*)(ws + WS_CU), (bf16_t*)(ws + WS_Q), (bf16_t*)(ws + WS_K), (bf16_t*)(ws + WS_V), (bf16_t*)(ws + WS_SZC), (bf16_t*)(ws + WS_SZA)};
        pg8::gemm_phase<pg8::EpiIn, pg8::StaticOrder, true, true>(lds, g, S, E); } SEAM(4);
    if (IN(5)) { int t5 = threadIdx.x; asm volatile("" : "+v"(t5)); const int l5 = t5 & 63;
        p5_conv(A, l5, wave, (bf16_t*)(ws + WS_BG));
        const bool xmap = (G * 4 == BATCH * 4 * (SEQ / 128)) && (G % 8 == 0); const int vcu = xmap ? (cid % 8) * (G / 8) + cid / 8 : cid;
        for (int ui = 0, u = xmap ? 4 * vcu : cid; u < BATCH * 4 * (SEQ / 128) && (!xmap || ui < 4); ++ui, u += xmap ? 1 : G) attn_unit(lds, (const bf16_t*)(ws + WS_Q), (bf16_t*)(ws + WS_Q), (const bf16_t*)(ws + WS_K), (const bf16_t*)(ws + WS_V), A.sinks, u, t5, l5, wave, xmap ? ui : 0); } SEAM(5);
    if (IN(6)) { pg8::Gemm g{(const bf16_t*)(ws + WS_BG), (const bf16_t*)(ws + WS_WC), M, DM, DM, (const bf16_t*)(ws + WS_Q), (const bf16_t*)(ws + WS_WA)}; pg8::DualOrder S; S.init(M, DM, G, cid);
        pg8::EpiDual E{(const bf16_t*)(ws + WS_SZC), (const bf16_t*)(ws + WS_SZA), (bf16_t*)(ws + WS_HB), lds + LDS_STG};
        pg8::gemm_phase<pg8::EpiDual, pg8::DualOrder, true, true>(lds, g, S, E); } SEAM(6);
    if (IN(7)) { pg8::Gemm g{(const bf16_t*)(ws + WS_HB), (const bf16_t*)(ws + WS_WO), M, DM, DM}; pg8::StaticOrder S; S.init(M, DM, G, cid);
        pg8::EpiRes<false, true, true, false> E{RES, RES, mods + MOD_GT2 * DM, (bf16_t*)(ws + WS_BG), A.g_ffn2, mods + MOD_SC3 * DM, (float*)(ws + WS_SSQ3), lds + LDS_STG};
        pg8::gemm_phase<pg8::EpiRes<false, true, true, false>, pg8::StaticOrder, true, true>(lds, g, S, E); } SEAM(7);
    if (IN(8)) { pg8::Gemm g{(const bf16_t*)(ws + WS_BG), (const bf16_t*)(ws + WS_W2GU), M, NGU, DM}; pg8::StaticOrder S; S.init(M, NGU, G, cid);
        pg8::EpiGU<true> E{(bf16_t*)(ws + WS_ACT2), (const float*)(ws + WS_SSQ3), (const float*)(ws + WS_BIAS3), lds + LDS_SCR};
        pg8::gemm_phase<pg8::EpiGU<true>, pg8::StaticOrder, true, true>(lds, g, S, E); } SEAM(8);
    if (IN(9)) { pg8::Gemm g{(const bf16_t*)(ws + WS_ACT2), (const bf16_t*)(ws + WS_W2DN), M, DM, DFF}; pg8::StaticOrder S; S.init(M, DM, G, cid);
        pg8::EpiRes<true, false, true, true> E{RES, (bf16_t*)(ws + WS_X3), mods + MOD_GT3 * DM, nullptr, nullptr, nullptr, (float*)(ws + WS_SSQF), lds + LDS_STG};
        pg8::gemm_phase<pg8::EpiRes<true, false, true, true>, pg8::StaticOrder, true, true>(lds, g, S, E); } SEAM(9);
    if (IN(10)) { int t10 = threadIdx.x; asm volatile("" : "+v"(t10)); p10_final(A, t10 & 63, wave, A.out); }
#undef IN
#undef SEAM
}

#ifndef MK_PER_PHASE
#define MK_PER_PHASE 0
#endif
extern "C" void kernel_launch(void* const* d_in, const int* in_sizes, int n_in, void* d_out, int out_size, void* d_ws, size_t ws_size, hipStream_t stream) {
    static int grid = 0;
    if (grid == 0) {
        if (n_in != 18 || in_sizes[0] != M * DM || out_size != M * DM || ws_size < WS_END) { fprintf(stderr, "kernel_launch: unexpected shapes (n_in %d, in0 %d, out %d, ws %zu); nothing launched\n", n_in, n_in > 0 ? in_sizes[0] : -1, out_size, ws_size); grid = -1; return; }
        int dev = 0, cus = 0, per_cu = 0;
        if (hipGetDevice(&dev) != hipSuccess || hipDeviceGetAttribute(&cus, hipDeviceAttributeMultiprocessorCount, dev) != hipSuccess) { grid = -1; return; }
        if (hipFuncSetAttribute((const void*)mk_fwd, hipFuncAttributeMaxDynamicSharedMemorySize, LDS_BYTES) != hipSuccess) { fprintf(stderr, "kernel_launch: hipFuncSetAttribute failed\n"); grid = -1; return; }
        if (hipOccupancyMaxActiveBlocksPerMultiprocessor(&per_cu, (const void*)mk_fwd, 512, LDS_BYTES) != hipSuccess || per_cu < 1) { fprintf(stderr, "kernel_launch: occupancy query failed (%d)\n", per_cu); (void)hipGetLastError(); per_cu = 1; }
        grid = cus * (per_cu > 1 ? 1 : per_cu);
    }
    if (grid < 0) return;
    if (hipMemsetAsync((char*)d_ws + WS_CTL, 0, CTL_BYTES, stream) != hipSuccess) { fprintf(stderr, "kernel_launch: memset failed\n"); return; }
    Args a{};
    const float** pp = &a.x;
    for (int i = 0; i < 18; ++i) pp[i] = (const float*)d_in[i];
    a.out = (float*)d_out; a.ws = (unsigned char*)d_ws;
    for (int i = 0; i < 32; ++i) { const float e = (float)(2 * i) / 64.0f; a.inv_freq[i] = 1.0f / powf(10000.0f, e); }
    const int nl = MK_PER_PHASE ? N_PHASES : 1;
    for (int li = 0; li < nl; ++li) {
        a.ph_lo = MK_PER_PHASE ? li : 0; a.ph_hi = MK_PER_PHASE ? li + 1 : N_PHASES;
        void* args[] = {&a};
        const hipError_t e = hipLaunchKernel((const void*)mk_fwd, dim3(grid), dim3(512), args, LDS_BYTES, stream);
        if (e != hipSuccess) { fprintf(stderr, "kernel_launch: launch %d failed: %s (grid %d)\n", li, hipGetErrorString(e), grid); break; }
    }
}
```
